# Optimizing an MI355X kernel written in HIP

```python
import math
import jax, jax.numpy as jnp
from jax import lax
import numpy as np

D_MODEL = 1024
BATCH = 8
SEQ = 2048
DEPTH = 4

HEAD_DIM = 64
DIL_GROUPS = ((128, 1), (512, 4), (2048, 16))
N_DIL = len(DIL_GROUPS)
HEADS_PER_DIL = 4
HA = N_DIL * HEADS_PER_DIL
HB = 6
HC = 6
N_HEADS = HA + HB + HC
MIX_WIDTH = N_HEADS * HEAD_DIM
BAND_BLOCK = 128
MOBA_BLOCK = 256
MOBA_TOPK = 3
MOBA_CHUNK = 32
SB_BLOCK = 128
N_BRANCH = 3
D_FF = -(-8 * D_MODEL // (3 * 256)) * 256
ROPE_THETA = 10000.0
NORM_EPS = 1e-6

kernel_name = "hybrid_gated_dilated_moba_stickbreaking_block"


def rms_norm(x, g):
    xf = x.astype(jnp.float32)
    y = xf * lax.rsqrt(jnp.mean(xf * xf, axis=-1, keepdims=True) + NORM_EPS)
    return (y * g.astype(jnp.float32)).astype(x.dtype)


def rope_tables(seq):
    pos = jnp.arange(seq, dtype=jnp.float32)
    inv = ROPE_THETA ** (-jnp.arange(0, HEAD_DIM, 2, dtype=jnp.float32) / HEAD_DIM)
    ang = pos[:, None] * inv[None, :]
    return jnp.cos(ang), jnp.sin(ang)


def apply_rope(x, cos, sin):
    x1, x2 = jnp.split(x, 2, axis=-1)
    cos = cos.astype(x.dtype)
    sin = sin.astype(x.dtype)
    return jnp.concatenate([x1 * cos - x2 * sin, x1 * sin + x2 * cos], axis=-1)


def _softmax_lse(s):
    mx = jnp.max(s, axis=-1, keepdims=True)
    e = jnp.exp(s - mx)
    den = jnp.sum(e, axis=-1, keepdims=True)
    return e / den, (mx + jnp.log(den))[..., 0]


def dilated_window_attention(q, k, v, window, dilation):
    B, H, S, Dh = q.shape
    L = S // dilation
    span = window // dilation
    blk = BAND_BLOCK
    nb = -(-L // blk)
    pad_r = nb * blk - L

    def to_sub(a):
        return a.reshape(B, H, L, dilation, Dh).transpose(0, 1, 3, 2, 4)

    qs, ks, vs = to_sub(q), to_sub(k), to_sub(v)
    qs = jnp.pad(qs, ((0, 0), (0, 0), (0, 0), (0, pad_r), (0, 0)))
    ks = jnp.pad(ks, ((0, 0), (0, 0), (0, 0), (blk, pad_r), (0, 0)))
    vs = jnp.pad(vs, ((0, 0), (0, 0), (0, 0), (blk, pad_r), (0, 0)))
    qb = qs.reshape(B, H, dilation, nb, blk, Dh)
    kb = ks.reshape(B, H, dilation, nb + 1, blk, Dh)
    vb = vs.reshape(B, H, dilation, nb + 1, blk, Dh)
    kw = jnp.concatenate([kb[:, :, :, :-1], kb[:, :, :, 1:]], axis=4)
    vw = jnp.concatenate([vb[:, :, :, :-1], vb[:, :, :, 1:]], axis=4)
    m = jnp.arange(nb)[:, None] * blk + jnp.arange(blk)[None, :]
    n = jnp.arange(nb)[:, None] * blk - blk + jnp.arange(2 * blk)[None, :]
    rel = m[:, :, None] - n[:, None, :]
    mask = (rel >= 0) & (rel <= span) & (n[:, None, :] >= 0)
    s = jnp.einsum("bhrnqd,bhrnkd->bhrnqk", qb, kw).astype(jnp.float32) * (HEAD_DIM ** -0.5)
    s = jnp.where(mask, s, -jnp.inf)
    p, lse = _softmax_lse(s)
    o = jnp.einsum("bhrnqk,bhrnkd->bhrnqd", p.astype(v.dtype), vw)
    o = o.reshape(B, H, dilation, nb * blk, Dh)[:, :, :, :L]
    o = o.transpose(0, 1, 3, 2, 4).reshape(B, H, S, Dh)
    lse = lse.reshape(B, H, dilation, nb * blk)[:, :, :, :L]
    lse = lse.transpose(0, 1, 3, 2).reshape(B, H, S)
    return o, lse


def dilated_mixture(qa, ka, va):
    outs, lses = [], []
    for g, (window, dilation) in enumerate(DIL_GROUPS):
        sl = slice(g * HEADS_PER_DIL, (g + 1) * HEADS_PER_DIL)
        o, lse = dilated_window_attention(qa[:, sl], ka[:, sl], va[:, sl], window, dilation)
        outs.append(o)
        lses.append(lse)
    w = jax.nn.softmax(jnp.stack(lses, axis=0), axis=0)
    o = jnp.sum(w[..., None] * jnp.stack(outs, axis=0).astype(jnp.float32), axis=0)
    return o.astype(qa.dtype)


def moba_attention(q, k, v):
    B, H, S, Dh = q.shape
    nblk = -(-S // MOBA_BLOCK)
    pad = nblk * MOBA_BLOCK - S
    kb = jnp.pad(k, ((0, 0), (0, 0), (0, pad), (0, 0))).reshape(B, H, nblk, MOBA_BLOCK, Dh)
    vb = jnp.pad(v, ((0, 0), (0, 0), (0, pad), (0, 0))).reshape(B, H, nblk, MOBA_BLOCK, Dh)
    topk = max(1, min(MOBA_TOPK, nblk - 1))
    own_blk = jnp.arange(S) // MOBA_BLOCK
    k_mean = jnp.mean(kb.astype(jnp.float32), axis=3)
    gate = jnp.einsum("bhsd,bhnd->bhsn", q.astype(jnp.float32), k_mean)
    past = jnp.arange(nblk)[None, :] < own_blk[:, None]
    gate = jnp.where(past, gate, -jnp.inf)
    _, sel = lax.top_k(gate, topk)
    valid = sel < own_blk[:, None]
    nq = S // MOBA_CHUNK
    scale = HEAD_DIM ** -0.5
    bi = jnp.arange(B)[:, None, None, None]
    hi = jnp.arange(H)[None, :, None, None]

    def to_chunks(a):
        return jnp.moveaxis(a.reshape(B, H, nq, MOBA_CHUNK, *a.shape[3:]), 2, 0)

    def chunk(args):
        i, qi, si, vi = args
        t = i * MOBA_CHUNK + jnp.arange(MOBA_CHUNK)
        ob = (i * MOBA_CHUNK) // MOBA_BLOCK
        k_own = lax.dynamic_index_in_dim(kb, ob, axis=2, keepdims=False)
        v_own = lax.dynamic_index_in_dim(vb, ob, axis=2, keepdims=False)
        k_sel = kb[bi, hi, si]
        v_sel = vb[bi, hi, si]
        s_sel = jnp.einsum("bhqd,bhqkld->bhqkl", qi, k_sel).astype(jnp.float32) * scale
        s_sel = jnp.where(vi[..., None], s_sel, -jnp.inf).reshape(B, H, MOBA_CHUNK, topk * MOBA_BLOCK)
        s_own = jnp.einsum("bhqd,bhld->bhql", qi, k_own).astype(jnp.float32) * scale
        key_pos = ob * MOBA_BLOCK + jnp.arange(MOBA_BLOCK)
        s_own = jnp.where(key_pos[None, :] <= t[:, None], s_own, -jnp.inf)
        p, _ = _softmax_lse(jnp.concatenate([s_sel, s_own], axis=-1))
        p = p.astype(v.dtype)
        p_sel = p[..., : topk * MOBA_BLOCK].reshape(B, H, MOBA_CHUNK, topk, MOBA_BLOCK)
        p_own = p[..., topk * MOBA_BLOCK:]
        return (jnp.einsum("bhqkl,bhqkld->bhqd", p_sel, v_sel)
                + jnp.einsum("bhql,bhld->bhqd", p_own, v_own))

    o = lax.map(chunk, (jnp.arange(nq), to_chunks(q), to_chunks(sel), to_chunks(valid)))
    return jnp.moveaxis(o, 0, 2).reshape(B, H, S, Dh)


def stick_breaking_attention(q, k, v):
    B, H, S, Dh = q.shape
    nq = S // SB_BLOCK
    key_pos = jnp.arange(S)
    scale = HEAD_DIM ** -0.5
    qc = jnp.moveaxis(q.reshape(B, H, nq, SB_BLOCK, Dh), 2, 0)

    def block(args):
        i, qi = args
        t = i * SB_BLOCK + jnp.arange(SB_BLOCK)
        past = key_pos[None, :] < t[:, None]
        z = jnp.einsum("bhqd,bhsd->bhqs", qi, k).astype(jnp.float32) * scale
        log_keep = jnp.where(past, jax.nn.log_sigmoid(-z), 0.0)
        after = lax.cumsum(log_keep, axis=3, reverse=True) - log_keep
        a = jnp.where(past, jnp.exp(jax.nn.log_sigmoid(z) + after), 0.0)
        return jnp.einsum("bhqs,bhsd->bhqd", a.astype(v.dtype), v)

    o = lax.map(block, (jnp.arange(nq), qc))
    return jnp.moveaxis(o, 0, 2).reshape(B, H, S, Dh)


def hybrid_mixer(h, w_in, w_br_a, w_br_b, w_br_c, w_gate, b_gate, w_out, cos, sin):
    B, S, D = h.shape
    qkv = (h @ w_in).reshape(B, S, 3, N_HEADS, HEAD_DIM).transpose(2, 0, 3, 1, 4)
    q, k, v = qkv[0], qkv[1], qkv[2]
    n_rot = HA + HB
    q_rot = apply_rope(q[:, :n_rot], cos, sin)
    k_rot = apply_rope(k[:, :n_rot], cos, sin)
    oa = dilated_mixture(q_rot[:, :HA], k_rot[:, :HA], v[:, :HA])
    ob = moba_attention(q_rot[:, HA:], k_rot[:, HA:], v[:, HA:n_rot])
    oc = stick_breaking_attention(q[:, n_rot:], k[:, n_rot:], v[:, n_rot:])

    def flat(o):
        return o.transpose(0, 2, 1, 3).reshape(B, S, -1)

    ya = flat(oa) @ w_br_a
    yb = flat(ob) @ w_br_b
    yc = flat(oc) @ w_br_c
    gates = jax.nn.sigmoid(h @ w_gate + b_gate).reshape(B, S, N_BRANCH, D)
    merged = gates[:, :, 0] * ya + gates[:, :, 1] * yb + gates[:, :, 2] * yc
    return merged @ w_out


def swiglu(h, w_gu, w_down):
    gt, up = jnp.split(h @ w_gu, 2, axis=-1)
    return (jax.nn.silu(gt) * up) @ w_down


def setup_inputs(seed: int = 0) -> dict:
    key = jax.random.key(seed)
    ks = jax.random.split(key, 16)

    def nrm(k, shape, fan_in, gain=1.0):
        return jax.random.normal(k, shape, jnp.float32) * (gain * fan_in ** -0.5)

    def gain_vec(k, shape):
        return 1.0 + 0.05 * jax.random.normal(k, shape, jnp.float32)

    D = D_MODEL
    return {
        "x": jax.random.normal(ks[0], (BATCH, SEQ, D), jnp.float32),
        "c": jax.random.normal(ks[1], (BATCH, D), jnp.float32),
        "w_ada": nrm(ks[2], (DEPTH, D, 6 * D), D, 0.5),
        "b_ada": 0.02 * jax.random.normal(ks[3], (DEPTH, 6 * D), jnp.float32),
        "norm1_g": gain_vec(ks[4], (DEPTH, D)),
        "w_in": nrm(ks[5], (DEPTH, D, 3 * MIX_WIDTH), D),
        "w_br_a": nrm(ks[6], (DEPTH, HEADS_PER_DIL * HEAD_DIM, D), HEADS_PER_DIL * HEAD_DIM),
        "w_br_b": nrm(ks[7], (DEPTH, HB * HEAD_DIM, D), HB * HEAD_DIM),
        "w_br_c": nrm(ks[8], (DEPTH, HC * HEAD_DIM, D), HC * HEAD_DIM),
        "w_gate": nrm(ks[9], (DEPTH, D, N_BRANCH * D), D),
        "b_gate": 0.02 * jax.random.normal(ks[10], (DEPTH, N_BRANCH * D), jnp.float32),
        "w_out": nrm(ks[11], (DEPTH, D, D), D),
        "norm2_g": gain_vec(ks[12], (DEPTH, D)),
        "w_gu": nrm(ks[13], (DEPTH, D, 2 * D_FF), D),
        "w_down": nrm(ks[14], (DEPTH, D_FF, D), D_FF),
        "final_g": gain_vec(ks[15], (D,)),
    }


def reference(x, c, w_ada, b_ada, norm1_g, w_in, w_br_a, w_br_b, w_br_c, w_gate, b_gate,
              w_out, norm2_g, w_gu, w_down, final_g):
    S = x.shape[1]
    cos, sin = rope_tables(S)
    c_act = jax.nn.silu(c)
    for l in range(DEPTH):
        mod = c_act @ w_ada[l] + b_ada[l]
        sh1, sc1, g1, sh2, sc2, g2 = [m[:, None, :] for m in jnp.split(mod, 6, axis=-1)]
        h = rms_norm(x, norm1_g[l]) * (1.0 + sc1) + sh1
        x = x + g1 * hybrid_mixer(h, w_in[l], w_br_a[l], w_br_b[l], w_br_c[l],
                                  w_gate[l], b_gate[l], w_out[l], cos, sin)
        h = rms_norm(x, norm2_g[l]) * (1.0 + sc2) + sh2
        x = x + g2 * swiglu(h, w_gu[l], w_down[l])
    return rms_norm(x, final_g)
```

```cpp
#include <hip/hip_runtime.h>
#include <hip/hip_cooperative_groups.h>
#include <cstdio>
#include <cstdint>
namespace cg = cooperative_groups;

#ifndef PHMASK
#define PHMASK 0xff
#endif
#define PHEN(k) ((PHMASK >> (k)) & 1)
#ifndef REPK
#define REPK -1
#endif
#ifndef REP_P0
#define REP_P0 1
#endif
#ifndef REP_B
#define REP_B 1
#endif
#ifndef REP_AC
#define REP_AC 1
#endif
#ifndef REP_ATT
#define REP_ATT 1
#endif
#ifndef REP_GU
#define REP_GU 1
#endif
#ifndef REP_SYNC
#define REP_SYNC 1
#endif
#ifndef REP_NORM
#define REP_NORM 1
#endif
#ifndef GALIGN
#define GALIGN true
#endif
#ifndef GSP2
#define GSP2 true
#endif
#ifndef MK_MULTI_LAUNCH
#define MK_MULTI_LAUNCH 0
#endif

namespace pg8 {
#define PG8_LAS __attribute__((address_space(3)))
typedef unsigned short bf16_t;
typedef short bf16x8 __attribute__((ext_vector_type(8)));
typedef float f32x4 __attribute__((ext_vector_type(4)));
typedef unsigned u32x4 __attribute__((ext_vector_type(4)));
constexpr int BM = 256, BK = 64, HALF = 128, HTB = HALF * BK * 2  , STAGE_BYTES = 8 * HTB, NXCD = 8, WGM = 8;

__host__ __device__ __forceinline__ int lds_byte(int r, int c) { const int st = (r >> 4) * 2 + (c >> 5), rr = r & 15, cc = c & 31, ob = rr * 64 + cc * 2; return st * 1024 + (ob ^ (((ob >> 9) & 1) << 5)); }
__host__ __device__ __forceinline__ void stage_rc(int b, int& R, int& C) { const int st = b / 1024, sb = b % 1024, swz = sb ^ (((sb >> 9) & 1) << 5); R = (st >> 1) * 16 + swz / 64; C = (st & 1) * 32 + (swz % 64) / 2; }
__host__ __device__ __forceinline__ int perm32(int rho) { const int n = rho >> 4, i = rho & 15; return 8 * (i >> 2) + 4 * n + (i & 3); }

struct Unit { int pm, pn; };
struct Gemm { const bf16_t* A; const bf16_t* Bt; int M, N, K; };

struct StaticOrder {
    int nM, nN, nwg, G, c;
    __host__ __device__ void init(int M, int N, int G_, int c_) { nM = M / BM; nN = N / BM; nwg = nM * nN; G = G_; c = c_; }
    __host__ __device__ bool next(int i, Unit& u) const {
        const long L = (long)i * G + c; if (L >= nwg) return false;
        int wgid = (int)L; { const int q = nwg / NXCD, r = nwg % NXCD, xcd = wgid % NXCD, off = wgid / NXCD; wgid = (xcd < r ? xcd * (q + 1) : r * (q + 1) + (xcd - r) * q) + off; }
        const int nig = WGM * nN, gid = wgid / nig, fm = gid * WGM, gsz = (nM - fm) < WGM ? (nM - fm) : WGM;
        u.pm = fm + ((wgid % nig) % gsz); u.pn = (wgid % nig) / gsz; return true;
    }
    __device__ __forceinline__ void a_ready(const Unit&) const {}
    __device__ __forceinline__ void done(const Unit&) const {}
};

__device__ __forceinline__ unsigned cvt_pk_bf16(float lo, float hi) { unsigned r; asm volatile("v_cvt_pk_bf16_f32 %0, %1, %2" : "=v"(r) : "v"(lo), "v"(hi)); return r; }

template <class Epi, class Sched, bool ALIGN_EPI = false, bool SP2 = false>
__device__ __forceinline__ void gemm_phase(PG8_LAS unsigned char* lds, const Gemm g, const Sched& S, const Epi& E, const int tid) {
    const int wid = __builtin_amdgcn_readfirstlane(tid >> 6), lane = tid & 63, wr = wid >> 2, wc = wid & 3, fr = lane & 15, fq = lane >> 4;
    const int K = g.K, nt = K / BK;
    unsigned voffA[2], voffB[2];
#pragma unroll
    for (int i = 0; i < 2; ++i) { int R, C; stage_rc(tid * 16 + i * 8192, R, C); const int Rb = Epi::PERM ? ((R & ~31) + perm32(R & 31)) : R;
        voffA[i] = (unsigned)(R * K + C) * 2u; voffB[i] = (unsigned)(Rb * K + C) * 2u; }
    const size_t kstep = (size_t)(BK * 2);
    const size_t hstep = (size_t)HALF * K * 2;
    const size_t tstep = 2 * hstep;
    const unsigned ldsw = (unsigned)wid * 1024u;
    const int aoff = lds_byte(wr * 64 + fr, fq * 8), boff = lds_byte(wc * 32 + fr, fq * 8);
#define PG8_SA(b, h) (((b) * 2 + (h)) * HTB)
#define PG8_SB(b, h) ((4 + (b) * 2 + (h)) * HTB)
#define PG8_STAGE(bufoff, gbase, voff) do { _Pragma("unroll") for (int _i = 0; _i < 2; ++_i) \
        __builtin_amdgcn_global_load_lds((const unsigned*)((const char*)(gbase) + (voff)[_i]), (PG8_LAS unsigned*)(lds + (bufoff) + ldsw + _i * 8192), 16, 0, 0); } while (0)
#define PG8_LDA(dst, b, h) do { _Pragma("unroll") for (int m = 0; m < 4; ++m) _Pragma("unroll") for (int k = 0; k < 2; ++k) dst[m][k] = *(const PG8_LAS bf16x8*)(lds + PG8_SA(b, h) + aoff + m * 2048 + k * 1024); } while (0)
#define PG8_LDB(dst, b, h) do { _Pragma("unroll") for (int n = 0; n < 2; ++n) _Pragma("unroll") for (int k = 0; k < 2; ++k) dst[n][k] = *(const PG8_LAS bf16x8*)(lds + PG8_SB(b, h) + boff + n * 2048 + k * 1024); } while (0)
#define PG8_MMA(ai, bj, At, Bt) do { __builtin_amdgcn_s_setprio(1); _Pragma("unroll") for (int m = 0; m < 4; ++m) _Pragma("unroll") for (int n = 0; n < 2; ++n) _Pragma("unroll") for (int k = 0; k < 2; ++k) \
        acc[ai][bj][m][n] = __builtin_amdgcn_mfma_f32_16x16x32_bf16(Bt[n][k], At[m][k], acc[ai][bj][m][n], 0, 0, 0); __builtin_amdgcn_s_setprio(0); } while (0)
#define PG8_WAIT_V(n) asm volatile("s_waitcnt vmcnt(" #n ")" ::: "memory")
#define PG8_WAIT_L(n) asm volatile("s_waitcnt lgkmcnt(" #n ")" ::: "memory")
#define PG8_BAR __builtin_amdgcn_s_barrier()
#define PG8_SCHED __builtin_amdgcn_sched_barrier(0)
    Unit cur, nxt; int ui = 0;
    if (!S.next(0, cur)) return;
    f32x4 acc[2][2][4][2];
#pragma unroll
    for (int a = 0; a < 2; ++a)
#pragma unroll
        for (int b = 0; b < 2; ++b)
#pragma unroll
            for (int m = 0; m < 4; ++m)
#pragma unroll
                for (int n = 0; n < 2; ++n) acc[a][b][m][n] = (f32x4){0.f, 0.f, 0.f, 0.f};
    bf16x8 At[4][2], B0[2][2], B1[2][2];
    const char* cA = (const char*)g.A + (size_t)cur.pm * tstep; const char* cB = (const char*)g.Bt + (size_t)cur.pn * tstep;
    S.a_ready(cur);
    if constexpr (SP2) {
        PG8_STAGE(PG8_SB(0, 0), cB, voffB); PG8_STAGE(PG8_SB(0, 1), cB + hstep, voffB); PG8_STAGE(PG8_SA(0, 0), cA, voffA); PG8_STAGE(PG8_SA(0, 1), cA + hstep, voffA);
        if (wr == 1) PG8_BAR;
        PG8_WAIT_V(2); PG8_BAR;
        PG8_STAGE(PG8_SB(1, 0), cB + kstep, voffB); PG8_STAGE(PG8_SA(1, 0), cA + kstep, voffA); PG8_STAGE(PG8_SB(1, 1), cB + hstep + kstep, voffB);
        PG8_WAIT_V(6); PG8_BAR;
    } else {
        PG8_STAGE(PG8_SB(0, 0), cB, voffB); PG8_STAGE(PG8_SA(0, 0), cA, voffA); PG8_STAGE(PG8_SB(0, 1), cB + hstep, voffB); PG8_STAGE(PG8_SA(0, 1), cA + hstep, voffA);
        if (wr == 1) PG8_BAR;
        PG8_WAIT_V(4); PG8_BAR;
        PG8_STAGE(PG8_SB(1, 0), cB + kstep, voffB); PG8_STAGE(PG8_SA(1, 0), cA + kstep, voffA); PG8_STAGE(PG8_SB(1, 1), cB + hstep + kstep, voffB);
        PG8_WAIT_V(6); PG8_BAR;
    }
    for (;;) {
        const bool has_next = S.next(ui + 1, nxt);
        const char* nA = has_next ? (const char*)g.A + (size_t)nxt.pm * tstep : cA; const char* nB = has_next ? (const char*)g.Bt + (size_t)nxt.pn * tstep : cB;
        for (int t = 0; t < nt; t += 2) {
            const bool last = (t == nt - 2);
            const char* a1 = cA + (size_t)(t + 1) * kstep;
            const char* a2 = last ? nA : cA + (size_t)(t + 2) * kstep; const char* b2 = last ? nB : cB + (size_t)(t + 2) * kstep;
            const char* a3 = a2 + kstep; const char* b3 = b2 + kstep;
            if (last && has_next) S.a_ready(nxt);
            if constexpr (SP2) {
            PG8_LDB(B0, 0, 0); PG8_LDB(B1, 0, 1); PG8_SCHED; PG8_LDA(At, 0, 0); PG8_STAGE(PG8_SA(1, 1), a1 + hstep, voffA);
            PG8_WAIT_V(8); PG8_WAIT_L(0); PG8_BAR; PG8_MMA(0, 0, At, B0); PG8_MMA(0, 1, At, B1); PG8_BAR; PG8_SCHED;
            PG8_LDA(At, 0, 1); PG8_STAGE(PG8_SB(0, 0), b2, voffB); PG8_STAGE(PG8_SB(0, 1), b2 + hstep, voffB); PG8_STAGE(PG8_SA(0, 0), a2, voffA);
            PG8_WAIT_V(8); PG8_WAIT_L(0); PG8_BAR; PG8_MMA(1, 0, At, B0); PG8_MMA(1, 1, At, B1); PG8_BAR; PG8_SCHED;
            PG8_LDB(B0, 1, 0); PG8_LDB(B1, 1, 1); PG8_SCHED; PG8_LDA(At, 1, 0); PG8_STAGE(PG8_SA(0, 1), a2 + hstep, voffA);
            PG8_WAIT_V(8); PG8_WAIT_L(0); PG8_BAR; PG8_MMA(0, 0, At, B0); PG8_MMA(0, 1, At, B1); PG8_BAR; PG8_SCHED;
            PG8_LDA(At, 1, 1); PG8_STAGE(PG8_SB(1, 0), b3, voffB); PG8_STAGE(PG8_SB(1, 1), b3 + hstep, voffB); PG8_STAGE(PG8_SA(1, 0), a3, voffA);
            PG8_WAIT_V(8); PG8_WAIT_L(0); PG8_BAR; PG8_MMA(1, 0, At, B0); PG8_MMA(1, 1, At, B1); PG8_BAR; PG8_SCHED;
            } else {
            PG8_LDB(B0, 0, 0); PG8_SCHED; PG8_LDA(At, 0, 0); PG8_STAGE(PG8_SA(1, 1), a1 + hstep, voffA);
            PG8_WAIT_L(8); PG8_BAR; PG8_WAIT_L(0); PG8_MMA(0, 0, At, B0); PG8_BAR; PG8_SCHED;
            PG8_LDB(B1, 0, 1); PG8_STAGE(PG8_SB(0, 0), b2, voffB);
            PG8_BAR; PG8_WAIT_L(0); PG8_MMA(0, 1, At, B1); PG8_BAR;
            PG8_LDA(At, 0, 1); PG8_STAGE(PG8_SA(0, 0), a2, voffA);
            PG8_BAR; PG8_WAIT_L(0); PG8_MMA(1, 0, At, B0); PG8_BAR; PG8_SCHED;
            PG8_STAGE(PG8_SB(0, 1), b2 + hstep, voffB);
            PG8_WAIT_V(6); PG8_BAR; PG8_MMA(1, 1, At, B1); PG8_BAR;
            PG8_LDB(B0, 1, 0); PG8_SCHED; PG8_LDA(At, 1, 0); PG8_STAGE(PG8_SA(0, 1), a2 + hstep, voffA);
            PG8_WAIT_L(8); PG8_BAR; PG8_WAIT_L(0); PG8_MMA(0, 0, At, B0); PG8_BAR; PG8_SCHED;
            PG8_LDB(B1, 1, 1); PG8_STAGE(PG8_SB(1, 0), b3, voffB);
            PG8_BAR; PG8_WAIT_L(0); PG8_MMA(0, 1, At, B1); PG8_BAR;
            PG8_LDA(At, 1, 1); PG8_STAGE(PG8_SA(1, 0), a3, voffA);
            PG8_BAR; PG8_WAIT_L(0); PG8_MMA(1, 0, At, B0); PG8_BAR; PG8_SCHED;
            PG8_STAGE(PG8_SB(1, 1), b3 + hstep, voffB);
            PG8_WAIT_V(6); PG8_BAR; PG8_MMA(1, 1, At, B1); PG8_BAR;
            }
        }
        if constexpr (ALIGN_EPI) { if (wr == 0) PG8_BAR; }
        if constexpr (!Epi::AFTER_DRAIN) { E(acc, cur, wr, wc, fr, fq); S.done(cur); }
        if (!has_next) break;
#pragma unroll
        for (int a = 0; a < 2; ++a)
#pragma unroll
            for (int b = 0; b < 2; ++b)
#pragma unroll
                for (int m = 0; m < 4; ++m)
#pragma unroll
                    for (int n = 0; n < 2; ++n) acc[a][b][m][n] = (f32x4){0.f, 0.f, 0.f, 0.f};
        cur = nxt; cA = nA; cB = nB; ++ui;
        if constexpr (ALIGN_EPI) { if (wr == 1) PG8_BAR; }
    }
    PG8_WAIT_V(0);
    if constexpr (!ALIGN_EPI) { if (wr == 0) PG8_BAR; }
    PG8_BAR;
    if constexpr (Epi::AFTER_DRAIN) { E.fused(acc, cur, wr, wc, fr, fq, lds, wid, lane); S.done(cur); }
#undef PG8_SA
#undef PG8_SB
#undef PG8_STAGE
#undef PG8_LDA
#undef PG8_LDB
#undef PG8_MMA
#undef PG8_WAIT_V
#undef PG8_WAIT_L
#undef PG8_BAR
#undef PG8_SCHED
}
}

#define LAS __attribute__((address_space(3)))
using pg8::bf16_t; using pg8::f32x4; using pg8::u32x4; using pg8::Unit;
typedef short bf16x8 __attribute__((ext_vector_type(8)));
typedef short s16x4 __attribute__((ext_vector_type(4)));
typedef short v4i16_t __attribute__((ext_vector_type(4)));
typedef float f32x16 __attribute__((ext_vector_type(16)));
typedef unsigned u32x2 __attribute__((ext_vector_type(2)));
typedef float f32x2_t __attribute__((ext_vector_type(2))); typedef __bf16 bf16x2_t __attribute__((ext_vector_type(2)));

constexpr int NWAVES = 8, NTHR = 512;
constexpr int DM = 1024, NB = 8, SEQ = 2048, DEPTH = 4, M = NB * SEQ;
constexpr int NHEAD = 24, MIXW = 1536, LDQ = 3 * MIXW  , NG = 3 * DM  , NQKVG = LDQ + NG  ;
constexpr int DFF = 2816, NGU = 2 * DFF;
constexpr float NORM_EPS = 1e-6f;
constexpr int LDS_BYTES = 147456;

constexpr size_t MiB = 1u << 20;
constexpr size_t WS_CTR = 0;
constexpr size_t WS_BAR = 32 * 1024;
constexpr size_t WS_MOD = 64 * 1024;
constexpr size_t WS_COS = WS_MOD + (size_t)DEPTH * NB * 6 * DM * 4;
constexpr size_t WS_SIN = WS_COS + (size_t)SEQ * 32 * 4;
constexpr size_t WS_KMEAN = WS_SIN + (size_t)SEQ * 32 * 4;
constexpr size_t WS_CNT = 2 * MiB;
constexpr size_t WS_XBUF = 2 * MiB + 256 * 1024;
constexpr size_t WS_W = 4 * MiB;
constexpr size_t W_QKVG = 0, W_A = W_QKVG + (size_t)NQKVG * DM * 2, W_B = W_A + (size_t)DM * 384 * 2, W_C = W_B + (size_t)DM * 384 * 2,
                 W_O = W_C + (size_t)DM * 384 * 2, W_GU = W_O + (size_t)DM * DM * 2, W_D = W_GU + (size_t)NGU * DM * 2, W_END = W_D + (size_t)DM * DFF * 2;
static_assert(W_END <= 40 * MiB, "weights");
constexpr size_t WS_H = 44 * MiB;
constexpr size_t WS_QKV = 76 * MiB;
constexpr size_t WS_GATES = 220 * MiB;
constexpr size_t WS_ATTA = 316 * MiB;
constexpr size_t WS_ATTB = WS_ATTA + (size_t)M * 384 * 2;
constexpr size_t WS_ATTC = WS_ATTB + (size_t)M * 384 * 2;
constexpr size_t WS_MERGED = 352 * MiB;
constexpr size_t WS_X16 = 384 * MiB;
constexpr size_t WS_END = 416 * MiB;

struct Params {
    const float *x, *c, *w_ada, *b_ada, *norm1_g, *w_in, *w_br_a, *w_br_b, *w_br_c, *w_gate, *b_gate, *w_out, *norm2_g, *w_gu, *w_down, *final_g;
    float* out; unsigned char* ws; int ph_lo, ph_hi;
};

__device__ __forceinline__ unsigned f2bf(float f) { unsigned u = __builtin_bit_cast(unsigned, f); return (u + 0x7fffu + ((u >> 16) & 1u)) >> 16; }
__device__ __forceinline__ unsigned pk2(float lo, float hi) { f32x2_t v = {lo, hi}; bf16x2_t b = __builtin_convertvector(v, bf16x2_t); return __builtin_bit_cast(unsigned, b); }
__device__ __forceinline__ float bf2f(unsigned short b) { return __uint_as_float((unsigned)b << 16); }
__device__ __forceinline__ float bflo(unsigned w) { return __uint_as_float(w << 16); }
__device__ __forceinline__ float bfhi(unsigned w) { return __uint_as_float(w & 0xffff0000u); }

template <int K> __device__ __forceinline__ float swz_xor(float v) { return __int_as_float(__builtin_amdgcn_ds_swizzle(__float_as_int(v), (K << 10) | 0x1f)); }
__device__ __forceinline__ float xor32_sum(float v) { auto rr = __builtin_amdgcn_permlane32_swap(__float_as_uint(v), __float_as_uint(v), false, false); return __uint_as_float(rr[0]) + __uint_as_float(rr[1]); }
__device__ __forceinline__ float xor32_max(float v) { auto rr = __builtin_amdgcn_permlane32_swap(__float_as_uint(v), __float_as_uint(v), false, false); return fmaxf(__uint_as_float(rr[0]), __uint_as_float(rr[1])); }
__device__ __forceinline__ float xor32_get(float v, int h) { auto rr = __builtin_amdgcn_permlane32_swap(__float_as_uint(v), __float_as_uint(v), false, false); return h == 0 ? __uint_as_float(rr[1]) : __uint_as_float(rr[0]); }
__device__ __forceinline__ float wave_sum(float v) {
    v += swz_xor<1>(v); v += swz_xor<2>(v); v += swz_xor<4>(v); v += swz_xor<8>(v); v += swz_xor<16>(v);
    return xor32_sum(v);
}
__device__ __forceinline__ float sigmoidf_(float x) { return __builtin_amdgcn_rcpf(1.0f + __expf(-x)); }


#define XB_TMO      128
#define XB_XCNT(j)  (256  + 64 * (j))
#define XB_XSUB(j)  (1280 + 64 * (j))
#define XB_XGEN(j)  (2304 + 64 * (j))
#define XB_TOP      3328
#define XB_TOPGEN   3392
#define XCD_BAR_WORDS 3456
#define XB_SPIN_CAP (1u << 22)
__device__ __forceinline__ unsigned xb_ld(unsigned* p)              { return __hip_atomic_load(p, __ATOMIC_RELAXED, __HIP_MEMORY_SCOPE_AGENT); }
__device__ __forceinline__ unsigned xb_add(unsigned* p, unsigned v) { return __hip_atomic_fetch_add(p, v, __ATOMIC_RELAXED, __HIP_MEMORY_SCOPE_AGENT); }
__device__ __forceinline__ unsigned xb_xcc_id() { return (unsigned)__builtin_amdgcn_s_getreg((3 << 11) | 20) & 0xFu; }
#define XB_SPIN(cond, bar) do { unsigned _sp = 0; while (cond) { __builtin_amdgcn_s_sleep(1); \
    if ((++_sp & 255u) == 0u) { if (xb_ld(&(bar)[XB_TMO])) break; if (_sp > XB_SPIN_CAP) { atomicAdd(&(bar)[XB_TMO], 1u); break; } } } } while (0)
struct XcdBarrier { unsigned* bar; unsigned x; volatile LAS unsigned* st; };
__device__ __forceinline__ XcdBarrier xcd_barrier_post(unsigned* bar, volatile LAS unsigned* st) {
    XcdBarrier b; b.bar = bar; b.x = xb_xcc_id(); b.st = st;
    if (threadIdx.x == 0) (void)xb_add(&bar[XB_XCNT(b.x)], 1u);
    return b;
}
__device__ __forceinline__ void xcd_barrier_complete(unsigned* bar, unsigned x, unsigned& nloc, unsigned& nx) {
    const unsigned G = gridDim.x * gridDim.y * gridDim.z;
    unsigned sum, cnt, mine, sp = 0u;
    for (;;) {
        sum = 0u; cnt = 0u; mine = 0u;
#pragma unroll
        for (unsigned j = 0; j < 16; ++j) { const unsigned c = xb_ld(&bar[XB_XCNT(j)]); sum += c; cnt += (c > 0u) ? 1u : 0u; mine = (j == x) ? c : mine; }
        if (sum == G) break;
        __builtin_amdgcn_s_sleep(1);
        if ((++sp & 255u) == 0u) { if (xb_ld(&bar[XB_TMO])) break; if (sp > XB_SPIN_CAP) { atomicAdd(&bar[XB_TMO], 1u); break; } }
    }
    nloc = mine > 0u ? mine : 1u; nx = cnt > 0u ? cnt : 1u;
}
__device__ __forceinline__ void xcd_barrier(unsigned* bar, volatile LAS unsigned* st, const int tid) {
    asm volatile("s_waitcnt vmcnt(0)" ::: "memory");
    __syncthreads();
    if (tid == 0) {
        const unsigned x = xb_xcc_id();
        __builtin_amdgcn_s_waitcnt(0);
        unsigned nloc = st[0], nx = st[1];
        if (nloc == 0u) { xcd_barrier_complete(bar, x, nloc, nx); st[0] = nloc; st[1] = nx; }
        const unsigned old = xb_add(&bar[XB_XSUB(x)], 1u);
        const unsigned gen = old / nloc;
        if (old + 1u == (gen + 1u) * nloc) {
            __builtin_amdgcn_fence(__ATOMIC_RELEASE, "agent");
            asm volatile("s_waitcnt vmcnt(0)" ::: "memory");
            const unsigned og = xb_add(&bar[XB_TOP], 1u);
            const unsigned tg = og / nx;
            if (og + 1u == (tg + 1u) * nx) xb_add(&bar[XB_TOPGEN], 1u);
            else XB_SPIN(xb_ld(&bar[XB_TOPGEN]) == tg, bar);
            __builtin_amdgcn_fence(__ATOMIC_ACQUIRE, "agent");
            xb_add(&bar[XB_XGEN(x)], 1u);
            asm volatile("s_waitcnt vmcnt(0)" ::: "memory");
        } else {
            XB_SPIN(xb_ld(&bar[XB_XGEN(x)]) == gen, bar);
            __builtin_amdgcn_fence(__ATOMIC_ACQUIRE, "agent");
            asm volatile("s_waitcnt vmcnt(0)" ::: "memory");
        }
    }
    __syncthreads();
}

struct EpiQKVG {
    static constexpr bool PERM = true, AFTER_DRAIN = false;
    bf16_t* qkv; bf16_t* gates; const float* bgate; const float* cosT; const float* sinT; float* kmean;
    __device__ __forceinline__ void operator()(const f32x4 (&acc)[2][2][4][2], const Unit& u, int wr, int wc, int fr, int fq) const {
        const int row0 = u.pm * 256 + wr * 64 + fr;
#pragma unroll
        for (int bj = 0; bj < 2; ++bj) {
            const int col = u.pn * 256 + bj * 128 + wc * 32 + 8 * fq;
            if (u.pn < 18) {
                const int which = col / MIXW, rem = col - which * MIXW, head = rem >> 6, dc = rem & 63;
                const bool rope = (which < 2) && (head < 18);
                const bool ksum_on = (which == 1) && (head >= 12) && (head < 18);
                const float sc = (which == 0) ? 0.125f * 1.4426950408889634f : 1.0f;
                if (rope) {
                    f32x4 c4[8], s4[8];
#pragma unroll
                    for (int i = 0; i < 8; ++i) { const int pos = (row0 + (i >> 2) * 128 + (i & 3) * 16) & (SEQ - 1);
                        c4[i] = *(const f32x4*)(cosT + (unsigned)(pos * 32 + (dc >> 1))); s4[i] = *(const f32x4*)(sinT + (unsigned)(pos * 32 + (dc >> 1))); }
                    float ks[8];
#pragma unroll
                    for (int j = 0; j < 8; ++j) ks[j] = 0.f;
#pragma unroll
                    for (int i = 0; i < 8; ++i) {
                        const int ai = i >> 2, m = i & 3, row = row0 + ai * 128 + m * 16;
                        const f32x4 v0 = acc[ai][bj][m][0], v1 = acc[ai][bj][m][1];
                        float r[8];
                        r[0] = v0[0] * c4[i][0] - v0[1] * s4[i][0]; r[1] = v0[0] * s4[i][0] + v0[1] * c4[i][0];
                        r[2] = v0[2] * c4[i][1] - v0[3] * s4[i][1]; r[3] = v0[2] * s4[i][1] + v0[3] * c4[i][1];
                        r[4] = v1[0] * c4[i][2] - v1[1] * s4[i][2]; r[5] = v1[0] * s4[i][2] + v1[1] * c4[i][2];
                        r[6] = v1[2] * c4[i][3] - v1[3] * s4[i][3]; r[7] = v1[2] * s4[i][3] + v1[3] * c4[i][3];
                        if (ksum_on) {
#pragma unroll
                            for (int j = 0; j < 8; ++j) ks[j] += r[j];
                        }
                        u32x4 w; w.x = pk2(r[0] * sc, r[1] * sc); w.y = pk2(r[2] * sc, r[3] * sc); w.z = pk2(r[4] * sc, r[5] * sc); w.w = pk2(r[6] * sc, r[7] * sc);
                        __builtin_nontemporal_store(w, (u32x4*)(qkv + (unsigned)(row * LDQ + col)));
                    }
                    if (ksum_on) {
#pragma unroll
                        for (int j = 0; j < 8; ++j) {
                            float v = ks[j];
                            v += swz_xor<1>(v); v += swz_xor<2>(v); v += swz_xor<4>(v); v += swz_xor<8>(v);
                            ks[j] = v;
                        }
                        if (fr == 0) {
                            float* dst = kmean + (size_t)(((u.pm >> 3) * 6 + (head - 12)) * 8 + (u.pm & 7)) * 64 + dc;
#pragma unroll
                            for (int j = 0; j < 8; ++j) atomicAdd(dst + j, ks[j]);
                        }
                    }
                } else {
#pragma unroll
                    for (int i = 0; i < 8; ++i) {
                        const int ai = i >> 2, m = i & 3, row = row0 + ai * 128 + m * 16;
                        const f32x4 v0 = acc[ai][bj][m][0] * sc, v1 = acc[ai][bj][m][1] * sc;
                        u32x4 w; w.x = pk2(v0[0], v0[1]); w.y = pk2(v0[2], v0[3]); w.z = pk2(v1[0], v1[1]); w.w = pk2(v1[2], v1[3]);
                        __builtin_nontemporal_store(w, (u32x4*)(qkv + (unsigned)(row * LDQ + col)));
                    }
                }
            } else {
                const int gcol = col - LDQ;
                const f32x4 b0 = *(const f32x4*)(bgate + gcol), b1 = *(const f32x4*)(bgate + gcol + 4);
#pragma unroll
                for (int ai = 0; ai < 2; ++ai)
#pragma unroll
                    for (int m = 0; m < 4; ++m) {
                        const int row = row0 + ai * 128 + m * 16;
                        const f32x4 v0 = acc[ai][bj][m][0] + b0, v1 = acc[ai][bj][m][1] + b1;
                        u32x4 w; w.x = pk2(sigmoidf_(v0[0]), sigmoidf_(v0[1])); w.y = pk2(sigmoidf_(v0[2]), sigmoidf_(v0[3]));
                        w.z = pk2(sigmoidf_(v1[0]), sigmoidf_(v1[1])); w.w = pk2(sigmoidf_(v1[2]), sigmoidf_(v1[3]));
                        __builtin_nontemporal_store(w, (u32x4*)(gates + (unsigned)(row * NG + gcol)));
                    }
            }
            asm volatile("" ::: "memory");
        }
    }
};
struct EpiBranch {
    static constexpr bool PERM = true, AFTER_DRAIN = false;
    const bf16_t* gates; bf16_t* merged;
    __device__ __forceinline__ void operator()(const f32x4 (&acc)[2][2][4][2], const Unit& us, int wr, int wc, int fr, int fq) const {
        const int br = us.pm >> 6; Unit u; u.pm = us.pm & 63; u.pn = us.pn & 3;
        const int row0 = u.pm * 256 + wr * 64 + fr;
#pragma unroll
        for (int ai = 0; ai < 2; ++ai)
#pragma unroll
            for (int m = 0; m < 4; ++m) {
                const int row = row0 + ai * 128 + m * 16;
#pragma unroll
                for (int bj = 0; bj < 2; ++bj) {
                    const int col = u.pn * 256 + bj * 128 + wc * 32 + 8 * fq;
                    const u32x4 g = *(const u32x4*)(gates + (unsigned)(row * NG + br * DM + col));
                    const f32x4 v0 = acc[ai][bj][m][0], v1 = acc[ai][bj][m][1];
                    float o[8];
                    o[0] = bflo(g.x) * v0[0]; o[1] = bfhi(g.x) * v0[1]; o[2] = bflo(g.y) * v0[2]; o[3] = bfhi(g.y) * v0[3];
                    o[4] = bflo(g.z) * v1[0]; o[5] = bfhi(g.z) * v1[1]; o[6] = bflo(g.w) * v1[2]; o[7] = bfhi(g.w) * v1[3];
                    bf16_t* dst = merged + (unsigned)(row * DM + col);
                    if (br > 0) {
                        const u32x4 p = *(const u32x4*)dst;
                        o[0] += bflo(p.x); o[1] += bfhi(p.x); o[2] += bflo(p.y); o[3] += bfhi(p.y);
                        o[4] += bflo(p.z); o[5] += bfhi(p.z); o[6] += bflo(p.w); o[7] += bfhi(p.w);
                    }
                    u32x4 w; w.x = pk2(o[0], o[1]); w.y = pk2(o[2], o[3]); w.z = pk2(o[4], o[5]); w.w = pk2(o[6], o[7]);
                    *(u32x4*)dst = w;
                }
                asm volatile("" ::: "memory");
            }
    }
};
struct RowStats {
    unsigned* xbuf;
    unsigned* cnt;
    __device__ __forceinline__ void run(const f32x4 (&v)[2][2][4][2], const Unit& u, int wr, int wc, int fr, int fq, LAS unsigned char* lds, int wid, int lane) const {
        LAS float* P = (LAS float*)lds;
        LAS float* S = (LAS float*)(lds + 4096);
#pragma unroll
        for (int ai = 0; ai < 2; ++ai)
#pragma unroll
            for (int m = 0; m < 4; ++m) {
                float q = 0.f;
#pragma unroll
                for (int bj = 0; bj < 2; ++bj)
#pragma unroll
                    for (int n = 0; n < 2; ++n) { const f32x4 x = v[ai][bj][m][n]; q += (x[0] * x[0] + x[1] * x[1]) + (x[2] * x[2] + x[3] * x[3]); }
                q += swz_xor<16>(q); q = xor32_sum(q);
                if (fq == 0) P[(ai * 128 + wr * 64 + m * 16 + fr) * 4 + wc] = q;
            }
        asm volatile("s_waitcnt lgkmcnt(0)" ::: "memory"); __builtin_amdgcn_s_barrier(); asm volatile("" ::: "memory");
        const int row = wid * 32 + (lane & 31);
        if (lane < 32) {
            const float t = (P[row * 4 + 0] + P[row * 4 + 1]) + (P[row * 4 + 2] + P[row * 4 + 3]);
            __hip_atomic_store(xbuf + ((size_t)(u.pm * 256 + row) * 4 + u.pn), __float_as_uint(t), __ATOMIC_RELAXED, __HIP_MEMORY_SCOPE_AGENT);
        }
        asm volatile("s_waitcnt vmcnt(0)" ::: "memory");
        if (lane == 0) __hip_atomic_fetch_add(cnt + 64 * u.pm, 1u, __ATOMIC_RELAXED, __HIP_MEMORY_SCOPE_AGENT);
        if (wid == 0) {
            unsigned sp = 0;
            for (;;) {
                if ((unsigned)__builtin_amdgcn_readfirstlane((int)__hip_atomic_load(cnt + 64 * u.pm, __ATOMIC_RELAXED, __HIP_MEMORY_SCOPE_AGENT)) >= 32u) break;
                if (++sp > (1u << 22)) break;
                __builtin_amdgcn_s_sleep(2);
            }
            __builtin_amdgcn_fence(__ATOMIC_ACQUIRE, "agent");
        }
        asm volatile("s_waitcnt vmcnt(0) lgkmcnt(0)" ::: "memory"); __builtin_amdgcn_s_barrier(); asm volatile("" ::: "memory");
        if (lane < 32) {
            const unsigned* slot = xbuf + (size_t)(u.pm * 256 + row) * 4;
            float t = 0.f;
#pragma unroll
            for (int k = 0; k < 4; ++k) t += __uint_as_float(__hip_atomic_load(slot + k, __ATOMIC_RELAXED, __HIP_MEMORY_SCOPE_AGENT));
            S[row] = 1.0f / sqrtf(t * (1.0f / DM) + NORM_EPS);
        }
        asm volatile("s_waitcnt lgkmcnt(0)" ::: "memory"); __builtin_amdgcn_s_barrier(); asm volatile("" ::: "memory");
    }
};
struct EpiResidNorm {
    static constexpr bool PERM = true, AFTER_DRAIN = true;
    const float* xin32; const bf16_t* xin16; bf16_t* xout16; float* yout; const float* gate; bf16_t* hout; const float* ng; const float* sc; const float* sh; RowStats st; int mode;
    __device__ __forceinline__ void operator()(const f32x4 (&)[2][2][4][2], const Unit&, int, int, int, int) const {}
    __device__ __forceinline__ void fused(f32x4 (&acc)[2][2][4][2], const Unit& u, int wr, int wc, int fr, int fq, LAS unsigned char* lds, int wid, int lane) const {
        const int row0 = u.pm * 256 + wr * 64 + fr;
        const unsigned boff = (unsigned)((u.pm >> 3) * 6 * DM);
#pragma unroll
        for (int bj = 0; bj < 2; ++bj) {
            const int col = u.pn * 256 + bj * 128 + wc * 32 + 8 * fq;
            const f32x4 g0 = *(const f32x4*)(gate + boff + col), g1 = *(const f32x4*)(gate + boff + col + 4);
            if (xin32) {
#pragma unroll
                for (int ai = 0; ai < 2; ++ai)
#pragma unroll
                    for (int m = 0; m < 4; ++m) {
                        const float* xp = xin32 + (unsigned)((row0 + ai * 128 + m * 16) * DM + col);
                        const f32x4 x0 = *(const f32x4*)xp, x1 = *(const f32x4*)(xp + 4);
                        acc[ai][bj][m][0] = x0 + g0 * acc[ai][bj][m][0]; acc[ai][bj][m][1] = x1 + g1 * acc[ai][bj][m][1];
                        asm volatile("" : "+v"(acc[ai][bj][m][0]), "+v"(acc[ai][bj][m][1]));
                        if (m & 1) asm volatile("" ::: "memory");
                    }
            } else {
#pragma unroll
                for (int ai = 0; ai < 2; ++ai)
#pragma unroll
                    for (int m = 0; m < 4; ++m) {
                        const u32x4 xw = *(const u32x4*)(xin16 + (unsigned)((row0 + ai * 128 + m * 16) * DM + col));
                        const f32x4 x0 = (f32x4){bflo(xw.x), bfhi(xw.x), bflo(xw.y), bfhi(xw.y)}, x1 = (f32x4){bflo(xw.z), bfhi(xw.z), bflo(xw.w), bfhi(xw.w)};
                        acc[ai][bj][m][0] = x0 + g0 * acc[ai][bj][m][0]; acc[ai][bj][m][1] = x1 + g1 * acc[ai][bj][m][1];
                        asm volatile("" : "+v"(acc[ai][bj][m][0]), "+v"(acc[ai][bj][m][1]));
                    }
            }
            asm volatile("" ::: "memory");
        }
        st.run(acc, u, wr, wc, fr, fq, lds, wid, lane);
        const LAS float* S = (const LAS float*)(lds + 4096);
#pragma unroll
        for (int bj = 0; bj < 2; ++bj) {
            const int col = u.pn * 256 + bj * 128 + wc * 32 + 8 * fq;
            f32x4 gv0 = *(const f32x4*)(ng + col), gv1 = *(const f32x4*)(ng + col + 4), sh0 = (f32x4){0.f, 0.f, 0.f, 0.f}, sh1 = sh0;
            if (mode == 0) { gv0 = gv0 * (*(const f32x4*)(sc + boff + col) + 1.0f); gv1 = gv1 * (*(const f32x4*)(sc + boff + col + 4) + 1.0f);
                             sh0 = *(const f32x4*)(sh + boff + col); sh1 = *(const f32x4*)(sh + boff + col + 4); }
#pragma unroll
            for (int ai = 0; ai < 2; ++ai)
#pragma unroll
                for (int m = 0; m < 4; ++m) {
                    const int r = ai * 128 + wr * 64 + m * 16 + fr;
                    const unsigned off = (unsigned)((u.pm * 256 + r) * DM + col);
                    const f32x4 x0 = acc[ai][bj][m][0], x1 = acc[ai][bj][m][1];
                    const float rs = S[r];
                    const f32x4 y0 = x0 * rs * gv0 + sh0, y1 = x1 * rs * gv1 + sh1;
                    if (mode == 0) {
                        u32x4 xw; xw.x = pk2(x0[0], x0[1]); xw.y = pk2(x0[2], x0[3]); xw.z = pk2(x1[0], x1[1]); xw.w = pk2(x1[2], x1[3]);
                        *(u32x4*)(xout16 + off) = xw;
                        u32x4 hw; hw.x = pk2(y0[0], y0[1]); hw.y = pk2(y0[2], y0[3]); hw.z = pk2(y1[0], y1[1]); hw.w = pk2(y1[2], y1[3]);
                        *(u32x4*)(hout + off) = hw;
                    } else {
                        *(f32x4*)(yout + off) = y0; *(f32x4*)(yout + off + 4) = y1;
                    }
                    if (m & 1) asm volatile("" ::: "memory");
                }
        }
    }
};
struct EpiSwiGLU {
    static constexpr bool PERM = true, AFTER_DRAIN = false;
    bf16_t* act;
    __device__ __forceinline__ void operator()(const f32x4 (&acc)[2][2][4][2], const Unit& u, int wr, int wc, int fr, int fq) const {
        const int row0 = u.pm * 256 + wr * 64 + fr;
        const int col = u.pn * 128 + wc * 32 + 8 * fq;
#pragma unroll
        for (int ai = 0; ai < 2; ++ai)
#pragma unroll
            for (int m = 0; m < 4; ++m) {
                const int row = row0 + ai * 128 + m * 16;
                float o[8];
#pragma unroll
                for (int n = 0; n < 2; ++n)
#pragma unroll
                    for (int j = 0; j < 4; ++j) { const float gt = acc[ai][0][m][n][j], up = acc[ai][1][m][n][j]; o[4 * n + j] = gt * sigmoidf_(gt) * up; }
                u32x4 w; w.x = pk2(o[0], o[1]); w.y = pk2(o[2], o[3]); w.z = pk2(o[4], o[5]); w.w = pk2(o[6], o[7]);
                __builtin_nontemporal_store(w, (u32x4*)(act + (unsigned)(row * DFF + col)));
                asm volatile("" ::: "memory");
            }
    }
};

struct BranchOrder {
    pg8::StaticOrder base;
    __device__ __forceinline__ bool next(int i, Unit& u) const { Unit t; if (!base.next(i / 3, t)) return false; const int br = i % 3; u.pm = br * 64 + t.pm; u.pn = br * 4 + t.pn; return true; }
    __device__ __forceinline__ void a_ready(const Unit&) const {}
    __device__ __forceinline__ void done(const Unit&) const {}
};
struct LimitOrder {
    pg8::StaticOrder base; int lim;
    __device__ __forceinline__ bool next(int i, Unit& u) const { return i < lim && base.next(i, u); }
    __device__ __forceinline__ void a_ready(const Unit&) const {}
    __device__ __forceinline__ void done(const Unit&) const {}
};
struct OneUnit {
    Unit u0;
    __device__ __forceinline__ bool next(int i, Unit& u) const { if (i != 0) return false; u = u0; return true; }
    __device__ __forceinline__ void a_ready(const Unit&) const {}
    __device__ __forceinline__ void done(const Unit&) const {}
};
__device__ __forceinline__ int rowmap(int kind, int n) {
    if (kind == 1) { const int which = n / MIXW, rem = n - which * MIXW, head = rem >> 6, d = rem & 63;
        const int dd = (which < 2 && head < 18) ? (2 * (d & 31) + (d >> 5)) : d; return which * MIXW + head * 64 + dd; }
    if (kind == 2) { const int up = n >= DFF, j = up ? n - DFF : n; return (j >> 7) * 256 + up * 128 + (j & 127); }
    return n;
}
__device__ __forceinline__ void transpose_item(const float* W, int K, int N, bf16_t* WT, int ldk, int row_off, int kind, LAS float* scr, int item, int lane) {
    const int nblk = N / 32, kb = item / nblk, nb = item % nblk, k0 = 64 * kb, n0 = 32 * nb;
#pragma unroll 8
    for (int i = 0; i < 32; ++i) { const int kk = 2 * i + (lane >> 5); scr[kk * 33 + (lane & 31)] = W[(size_t)(k0 + kk) * N + n0 + (lane & 31)]; }
    asm volatile("s_waitcnt lgkmcnt(0)" ::: "memory");
    const int c = lane & 7;
#pragma unroll
    for (int j = 0; j < 4; ++j) { const int n = (lane >> 3) + 8 * j; const LAS float* s = scr + (8 * c) * 33 + n;
        u32x4 o; o.x = pk2(s[0 * 33], s[1 * 33]); o.y = pk2(s[2 * 33], s[3 * 33]); o.z = pk2(s[4 * 33], s[5 * 33]); o.w = pk2(s[6 * 33], s[7 * 33]);
        *(u32x4*)(WT + (size_t)(row_off + rowmap(kind, n0 + n)) * ldk + k0 + 8 * c) = o; }
    asm volatile("s_waitcnt lgkmcnt(0)" ::: "memory");
}

#define MFMA32(a, b, c) __builtin_amdgcn_mfma_f32_32x32x16_bf16((a), (b), (c), 0, 0, 0)
constexpr int VROW = 144;
constexpr int VTILE = 32 * VROW;
__device__ __forceinline__ int crow(int r, int h) { return (r & 3) + 8 * (r >> 2) + 4 * h; }
__device__ __forceinline__ s16x4 vtr(const LAS unsigned char* p) { return __builtin_bit_cast(s16x4, __builtin_amdgcn_ds_read_tr16_b64_v4i16((LAS v4i16_t*)p)); }

struct WaveCtx { int lane, q, h; LAS unsigned char* vl; int troff; };

__device__ __forceinline__ void load_q(bf16x8 (&qf)[4], const bf16_t* qrow, int h) {
#pragma unroll
    for (int ks = 0; ks < 4; ++ks) qf[ks] = *(const bf16x8*)(qrow + 16 * ks + 8 * h);
}
template <bool CLAMP>
__device__ __forceinline__ void load_k(bf16x8 (&kf)[4], const bf16_t* kbase, int k0, int kst, const WaveCtx& c) {
    int kp = k0 + kst * c.q; if (CLAMP) kp = kp < 0 ? 0 : (kp > SEQ - 1 ? SEQ - 1 : kp);
    const bf16_t* kr = kbase + (size_t)kp * LDQ + 8 * c.h;
#pragma unroll
    for (int ks = 0; ks < 4; ++ks) kf[ks] = *(const bf16x8*)(kr + 16 * ks);
}
template <bool CLAMP>
__device__ __forceinline__ void load_v(u32x4 (&vr)[4], const bf16_t* vbase, int k0, int kst, const WaveCtx& c) {
#pragma unroll
    for (int i = 0; i < 4; ++i) { const int p = c.lane + 64 * i, n = p >> 3; int kp = k0 + kst * n; if (CLAMP) kp = kp < 0 ? 0 : (kp > SEQ - 1 ? SEQ - 1 : kp);
        vr[i] = *(const u32x4*)(vbase + (size_t)kp * LDQ + (p & 7) * 8); }
}
__device__ __forceinline__ void store_v(const u32x4 (&vr)[4], const WaveCtx& c) {
#pragma unroll
    for (int i = 0; i < 4; ++i) { const int p = c.lane + 64 * i, n = p >> 3; *(LAS u32x4*)(c.vl + n * VROW + (p & 7) * 16) = vr[i]; }
}
struct VF { bf16x8 v[2][2]; };
__device__ __forceinline__ void read_vf_at(VF& f, const LAS unsigned char* vb, const WaveCtx& c) {
#pragma unroll
    for (int dt = 0; dt < 2; ++dt)
#pragma unroll
        for (int s2 = 0; s2 < 2; ++s2) {
            const LAS unsigned char* a = vb + c.troff + (16 * s2) * VROW + dt * 64;
            const s16x4 lo = vtr(a), hi = vtr(a + 8 * VROW);
            f.v[dt][s2] = (bf16x8){lo[0], lo[1], lo[2], lo[3], hi[0], hi[1], hi[2], hi[3]};
        }
}
__device__ __forceinline__ void read_vf(VF& f, const WaveCtx& c) {
#pragma unroll
    for (int dt = 0; dt < 2; ++dt)
#pragma unroll
        for (int s2 = 0; s2 < 2; ++s2) {
            const LAS unsigned char* a = c.vl + c.troff + (16 * s2) * VROW + dt * 64;
            const s16x4 lo = vtr(a), hi = vtr(a + 8 * VROW);
            f.v[dt][s2] = (bf16x8){lo[0], lo[1], lo[2], lo[3], hi[0], hi[1], hi[2], hi[3]};
        }
}
__device__ __forceinline__ void pv(f32x16 (&o)[2], const f32x16& p, const VF& f) {
    bf16x8 pb[2];
#pragma unroll
    for (int s2 = 0; s2 < 2; ++s2) {
        u32x4 w; w.x = pk2(p[8 * s2 + 0], p[8 * s2 + 1]); w.y = pk2(p[8 * s2 + 2], p[8 * s2 + 3]); w.z = pk2(p[8 * s2 + 4], p[8 * s2 + 5]); w.w = pk2(p[8 * s2 + 6], p[8 * s2 + 7]);
        pb[s2] = __builtin_bit_cast(bf16x8, w);
    }
#pragma unroll
    for (int s2 = 0; s2 < 2; ++s2)
#pragma unroll
        for (int dt = 0; dt < 2; ++dt) o[dt] = MFMA32(f.v[dt][s2], pb[s2], o[dt]);
}
__device__ __forceinline__ f32x16 qk(const bf16x8 (&kf)[4], const bf16x8 (&qf)[4]) {
    f32x16 s0, s1;
#pragma unroll
    for (int r = 0; r < 16; ++r) { s0[r] = 0.f; s1[r] = 0.f; }
    s0 = MFMA32(kf[0], qf[0], s0); s1 = MFMA32(kf[2], qf[2], s1);
    s0 = MFMA32(kf[1], qf[1], s0); s1 = MFMA32(kf[3], qf[3], s1);
    return s0 + s1;
}
__device__ __forceinline__ f32x16 qk_ref(const bf16x8 (&kf)[4], const bf16x8 (&qf)[4], const f32x16& negm) {
    f32x16 s = MFMA32(kf[0], qf[0], negm);
    s = MFMA32(kf[1], qf[1], s); s = MFMA32(kf[2], qf[2], s); s = MFMA32(kf[3], qf[3], s);
    return s;
}
struct SoftState { f32x16 o[2]; f32x16 negm; float m, l; };
struct KV { bf16x8 kf[4]; u32x4 vr[4]; };
template <bool CLAMP>
__device__ __forceinline__ void issue_kv(KV& t, const bf16_t* kbase, const bf16_t* vbase, int k0, int kst, const WaveCtx& c) { load_k<CLAMP>(t.kf, kbase, k0, kst, c); load_v<CLAMP>(t.vr, vbase, k0, kst, c); }
__device__ __forceinline__ void soft_init(SoftState& st) {
#pragma unroll
    for (int r = 0; r < 16; ++r) { st.o[0][r] = 0.f; st.o[1][r] = 0.f; }
    st.m = 0.f; st.l = 0.f;
#pragma unroll
    for (int r = 0; r < 16; ++r) st.negm[r] = 0.f;
}
template <int MODE>
__device__ __forceinline__ void soft_compute(SoftState& st, const bf16x8 (&qf)[4], const KV& t, int k0, int kst, int qp, int W, int dilm1, bool lane_ok, bool diag, const WaveCtx& c) {
    store_v(t.vr, c);
    VF vf; read_vf(vf, c);
    f32x16 s = qk_ref(t.kf, qf, st.negm);
    if (MODE == 0) {
        const int relb = qp - k0;
        const bool cls_ok = ((relb & dilm1) == 0);
#pragma unroll
        for (int r = 0; r < 16; ++r) {
            const unsigned rel = (unsigned)(relb - kst * crow(r, c.h));
            s[r] = (cls_ok && rel <= (unsigned)W) ? s[r] : -1e30f;
        }

    } else if (diag) {
#pragma unroll
        for (int r = 0; r < 16; ++r) { const int kp = k0 + crow(r, c.h); s[r] = (kp <= qp) ? s[r] : -1e30f; }
    } else if (__ballot(!lane_ok) != 0ull) {
#pragma unroll
        for (int r = 0; r < 16; ++r) s[r] = lane_ok ? s[r] : -1e30f;
    }
    float mx = fmaxf(fmaxf(s[0], s[1]), fmaxf(s[2], s[3]));
#pragma unroll
    for (int r = 4; r < 16; r += 4) mx = fmaxf(mx, fmaxf(fmaxf(s[r], s[r + 1]), fmaxf(s[r + 2], s[r + 3])));
    mx = xor32_max(mx);
    if (__ballot(mx > 8.0f) != 0ull) {
        const float d = fmaxf(mx, 0.f), scl = __builtin_amdgcn_exp2f(-d);
        st.l *= scl; st.m += d;
        const float nm = -st.m;
#pragma unroll
        for (int r = 0; r < 16; ++r) { st.o[0][r] *= scl; st.o[1][r] *= scl; s[r] -= d; st.negm[r] = nm; }
    }
    float ps = 0.f;
#pragma unroll
    for (int r = 0; r < 16; ++r) { const float p = __builtin_amdgcn_exp2f(s[r]); s[r] = p; ps += p; }
    st.l += xor32_sum(ps);
    pv(st.o, s, vf);
}
__device__ __forceinline__ void store_o(const f32x16 (&o)[2], float inv, bf16_t* orow, const WaveCtx& c) {
#pragma unroll
    for (int dt = 0; dt < 2; ++dt)
#pragma unroll
        for (int r4 = 0; r4 < 4; ++r4) {
            u32x2 w; w.x = pk2(o[dt][4 * r4] * inv, o[dt][4 * r4 + 1] * inv); w.y = pk2(o[dt][4 * r4 + 2] * inv, o[dt][4 * r4 + 3] * inv);
            *(u32x2*)(orow + 32 * dt + 8 * r4 + 4 * c.h) = w;
        }
}

__device__ __forceinline__ void unit_A(const bf16_t* qkv, bf16_t* outA, int b, int slot, int blk, int w, const WaveCtx& c) {
    const int cls0 = (w & 3) + 8 * (w >> 2), cls = cls0 + 4 * (c.q >> 4), qp = 256 * blk + cls + 16 * (c.q & 15);
    const bf16_t* rowb = qkv + (size_t)b * SEQ * LDQ;
    SoftState st; soft_init(st);
    for (int g = 0; g < 3; ++g) {
        const int dil = 1 << (2 * g), W = 128 * dil, head = 4 * g + slot;
        bf16x8 qf[4]; load_q(qf, rowb + (size_t)qp * LDQ + head * 64, c.h);
        const bf16_t* kbase = rowb + MIXW + head * 64; const bf16_t* vbase = rowb + 2 * MIXW + head * 64;
        int ks0, ks1 = 0, n0, n1 = 0;
        if (g == 0) { ks0 = 256 * blk + cls0 - 128; if (ks0 < 0) ks0 = 0; const int kend = 256 * blk + cls0 + 4 + 240; n0 = ((kend - ks0) + 1 + 31) >> 5; }
        else if (g == 1) {
            const int lo = 256 * blk - W;
            ks0 = (lo < 0) ? (cls0 & 3) : (cls0 + lo);
            n0 = ((256 * blk + cls0 + 4 + 240 - ks0) / dil + 1 + 31) >> 5;
        } else {
            const int lo = 256 * blk - W;
            const int c0 = cls0, c1 = cls0 + 4;
            ks0 = (lo < 0) ? (c0 & (dil - 1)) : (c0 + lo); ks1 = (lo < 0) ? (c1 & (dil - 1)) : (c1 + lo);
            n0 = ((256 * blk + c0 + 240 - ks0) / dil + 1 + 31) >> 5; n1 = ((256 * blk + c1 + 240 - ks1) / dil + 1 + 31) >> 5;
        }
        const int ntot = n0 + n1, step = 32 * dil;
        KV ta, tb;
        issue_kv<true>(ta, kbase, vbase, ks0, dil, c);
#define A_K0(i) (((i) < n0) ? (ks0 + step * (i)) : (ks1 + step * ((i) - n0)))
        for (int i = 0; i < ntot; i += 2) {
            if (i + 1 < ntot) issue_kv<true>(tb, kbase, vbase, A_K0(i + 1), dil, c);
            soft_compute<0>(st, qf, ta, A_K0(i), dil, qp, W, dil - 1, true, false, c);
            if (i + 1 >= ntot) break;
            if (i + 2 < ntot) issue_kv<true>(ta, kbase, vbase, A_K0(i + 2), dil, c);
            soft_compute<0>(st, qf, tb, A_K0(i + 1), dil, qp, W, dil - 1, true, false, c);
        }
#undef A_K0
    }
    store_o(st.o, __builtin_amdgcn_rcpf(st.l), outA + (size_t)(b * SEQ + qp) * 384 + slot * 64, c);
}
constexpr int A2_T = 40960, A2_STRIDE = 68, A2_M = A2_T + 256 * A2_STRIDE * 4, A2_L = A2_M + 1024;
__device__ __forceinline__ void unit_A2(const bf16_t* qkv, bf16_t* outA, int b, int slot, int blk, int w, LAS unsigned char* lds, const WaveCtx& c) {
    const bf16_t* rowb = qkv + (size_t)b * SEQ * LDQ;
    SoftState st; soft_init(st);
    {
        const int qp1 = 256 * blk + 32 * w + c.q, head = slot;
        bf16x8 qf[4]; load_q(qf, rowb + (size_t)qp1 * LDQ + head * 64, c.h);
        const bf16_t* kbase = rowb + MIXW + head * 64; const bf16_t* vbase = rowb + 2 * MIXW + head * 64;
        int ks0 = 256 * blk + 32 * w - 128; if (ks0 < 0) ks0 = 0;
        const int ntot = ((256 * blk + 32 * w + 31 - ks0) + 1 + 31) >> 5;
        KV ta, tb;
        issue_kv<true>(ta, kbase, vbase, ks0, 1, c);
        for (int i = 0; i < ntot; i += 2) {
            if (i + 1 < ntot) issue_kv<true>(tb, kbase, vbase, ks0 + 32 * (i + 1), 1, c);
            soft_compute<0>(st, qf, ta, ks0 + 32 * i, 1, qp1, 128, 0, true, false, c);
            if (i + 1 >= ntot) break;
            if (i + 2 < ntot) issue_kv<true>(ta, kbase, vbase, ks0 + 32 * (i + 2), 1, c);
            soft_compute<0>(st, qf, tb, ks0 + 32 * (i + 1), 1, qp1, 128, 0, true, false, c);
        }
    }
    LAS float* T = (LAS float*)(lds + A2_T); LAS float* Mt = (LAS float*)(lds + A2_M); LAS float* Lt = (LAS float*)(lds + A2_L);
    {
        const int qi = 32 * w + c.q;
#pragma unroll
        for (int dt = 0; dt < 2; ++dt)
#pragma unroll
            for (int r4 = 0; r4 < 4; ++r4)
                *(LAS f32x4*)(T + qi * A2_STRIDE + 32 * dt + 8 * r4 + 4 * c.h) = (f32x4){st.o[dt][4 * r4], st.o[dt][4 * r4 + 1], st.o[dt][4 * r4 + 2], st.o[dt][4 * r4 + 3]};
        if (c.h == 0) { Mt[qi] = st.m; Lt[qi] = st.l; }
    }
    __syncthreads();
    const int cls0 = (w & 3) + 8 * (w >> 2), cls = cls0 + 4 * (c.q >> 4), qi2 = cls + 16 * (c.q & 15), qp = 256 * blk + qi2;
    {
#pragma unroll
        for (int dt = 0; dt < 2; ++dt)
#pragma unroll
            for (int r4 = 0; r4 < 4; ++r4) {
                const f32x4 v = *(const LAS f32x4*)(T + qi2 * A2_STRIDE + 32 * dt + 8 * r4 + 4 * c.h);
                st.o[dt][4 * r4] = v[0]; st.o[dt][4 * r4 + 1] = v[1]; st.o[dt][4 * r4 + 2] = v[2]; st.o[dt][4 * r4 + 3] = v[3];
            }
        st.m = Mt[qi2]; st.l = Lt[qi2];
        const float nm = -st.m;
#pragma unroll
        for (int r = 0; r < 16; ++r) st.negm[r] = nm;
    }
    for (int g = 1; g < 3; ++g) {
        const int dil = 1 << (2 * g), W = 128 * dil, head = 4 * g + slot;
        bf16x8 qf[4]; load_q(qf, rowb + (size_t)qp * LDQ + head * 64, c.h);
        const bf16_t* kbase = rowb + MIXW + head * 64; const bf16_t* vbase = rowb + 2 * MIXW + head * 64;
        int ks0, ks1 = 0, n0, n1 = 0;
        const int lo = 256 * blk - W;
        if (g == 1) { ks0 = (lo < 0) ? (cls0 & 3) : (cls0 + lo); n0 = ((256 * blk + cls0 + 4 + 240 - ks0) / dil + 1 + 31) >> 5; }
        else { const int c0 = cls0, c1 = cls0 + 4;
            ks0 = (lo < 0) ? (c0 & (dil - 1)) : (c0 + lo); ks1 = (lo < 0) ? (c1 & (dil - 1)) : (c1 + lo);
            n0 = ((256 * blk + c0 + 240 - ks0) / dil + 1 + 31) >> 5; n1 = ((256 * blk + c1 + 240 - ks1) / dil + 1 + 31) >> 5; }
        const int ntot = n0 + n1, step = 32 * dil;
        KV ta, tb;
        issue_kv<true>(ta, kbase, vbase, ks0, dil, c);
#define A_K0(i) (((i) < n0) ? (ks0 + step * (i)) : (ks1 + step * ((i) - n0)))
        for (int i = 0; i < ntot; i += 2) {
            if (i + 1 < ntot) issue_kv<true>(tb, kbase, vbase, A_K0(i + 1), dil, c);
            soft_compute<0>(st, qf, ta, A_K0(i), dil, qp, W, dil - 1, true, false, c);
            if (i + 1 >= ntot) break;
            if (i + 2 < ntot) issue_kv<true>(ta, kbase, vbase, A_K0(i + 2), dil, c);
            soft_compute<0>(st, qf, tb, A_K0(i + 1), dil, qp, W, dil - 1, true, false, c);
        }
#undef A_K0
    }
    store_o(st.o, __builtin_amdgcn_rcpf(st.l), outA + (size_t)(b * SEQ + qp) * 384 + slot * 64, c);
}
__device__ __forceinline__ void soft_compute_lds(SoftState& st, const bf16x8 (&qf)[4], const LAS unsigned char* kc, const LAS unsigned char* vc, int k0, int qp, bool lane_ok, bool diag, const WaveCtx& c) {
    bf16x8 kf[4];
#pragma unroll
    for (int ks = 0; ks < 4; ++ks) kf[ks] = *(const LAS bf16x8*)(kc + c.q * VROW + ks * 32 + c.h * 16);
    f32x16 s = qk_ref(kf, qf, st.negm);
    if (diag) {
#pragma unroll
        for (int r = 0; r < 16; ++r) { const int kp = k0 + crow(r, c.h); s[r] = (kp <= qp) ? s[r] : -1e30f; }
    } else if (__ballot(!lane_ok) != 0ull) {
#pragma unroll
        for (int r = 0; r < 16; ++r) s[r] = lane_ok ? s[r] : -1e30f;
    }
    float mx = fmaxf(fmaxf(s[0], s[1]), fmaxf(s[2], s[3]));
#pragma unroll
    for (int r = 4; r < 16; r += 4) mx = fmaxf(mx, fmaxf(fmaxf(s[r], s[r + 1]), fmaxf(s[r + 2], s[r + 3])));
    mx = xor32_max(mx);
    if (__ballot(mx > 8.0f) != 0ull) {
        const float d = fmaxf(mx, 0.f), scl = __builtin_amdgcn_exp2f(-d);
        st.l *= scl; st.m += d;
        const float nm = -st.m;
#pragma unroll
        for (int r = 0; r < 16; ++r) { st.o[0][r] *= scl; st.o[1][r] *= scl; s[r] -= d; st.negm[r] = nm; }
    }
    float ps = 0.f;
#pragma unroll
    for (int r = 0; r < 16; ++r) { const float p = __builtin_amdgcn_exp2f(s[r]); s[r] = p; ps += p; }
    st.l += xor32_sum(ps);
    VF vf; read_vf_at(vf, vc, c);
    pv(st.o, s, vf);
}
constexpr int BST = 128 * VROW;
__device__ __forceinline__ void wg_unit_B(const bf16_t* qkv, const float* kmean, bf16_t* outB, int b, int hb, int qb, LAS unsigned char* lds, int wid, const WaveCtx& c, int tid) {
    const int own = qb, qt = 8 * qb + wid, qp = 32 * qt + c.q, head = 12 + hb;
    const bf16_t* rowb = qkv + (size_t)b * SEQ * LDQ;
    bf16x8 qf[4]; load_q(qf, rowb + (size_t)qp * LDQ + head * 64, c.h);
    const bf16_t* kbase = rowb + MIXW + head * 64; const bf16_t* vbase = rowb + 2 * MIXW + head * 64;
    float gate[7];
#pragma unroll
    for (int n = 0; n < 7; ++n) {
        gate[n] = -INFINITY;
        if (n < own) {
            const float* km = kmean + (size_t)((b * 6 + hb) * 8 + n) * 64 + 8 * c.h;
            float a = 0.f;
#pragma unroll
            for (int ks = 0; ks < 4; ++ks) {
                const f32x4 k0 = *(const f32x4*)(km + 16 * ks), k1 = *(const f32x4*)(km + 16 * ks + 4);
#pragma unroll
                for (int j = 0; j < 4; ++j) { a += bf2f((unsigned short)qf[ks][j]) * k0[j]; a += bf2f((unsigned short)qf[ks][4 + j]) * k1[j]; }
            }
            a = xor32_sum(a);
            gate[n] = a;
        }
    }
    unsigned sel = 0;
#pragma unroll
    for (int n = 0; n < 7; ++n) {
        if (n < own) {
            int rank = 0;
#pragma unroll
            for (int m2 = 0; m2 < 7; ++m2) if (m2 < own && m2 != n) rank += (gate[m2] > gate[n] || (gate[m2] == gate[n] && m2 < n)) ? 1 : 0;
            if (rank < 3) sel |= 1u << n;
        }
    }
    unsigned vis = 0;
#pragma unroll
    for (int n = 0; n < 7; ++n) if (n < own && __ballot((sel >> n) & 1u) != 0ull) vis |= 1u << n;
    LAS unsigned* wv = (LAS unsigned*)(lds + 131072 + 128);
    if (tid == 0) *wv = 0u;
    __syncthreads();
    if (c.lane == 0 && vis) __hip_atomic_fetch_or((unsigned*)wv, vis, __ATOMIC_RELAXED, __HIP_MEMORY_SCOPE_WORKGROUP);
    __syncthreads();
    const unsigned visw = *wv;
    const int nsteps = 2 * (__popc(visw) + 1);
    const int srow = tid >> 3, spc = tid & 7;
    u32x4 kr[2], vr[2];
#define BW_LOAD(blk_, half_) do { const int r0_ = 256 * (blk_) + 128 * (half_) + srow; \
        kr[0] = *(const u32x4*)(kbase + (size_t)r0_ * LDQ + spc * 8); kr[1] = *(const u32x4*)(kbase + (size_t)(r0_ + 64) * LDQ + spc * 8); \
        vr[0] = *(const u32x4*)(vbase + (size_t)r0_ * LDQ + spc * 8); vr[1] = *(const u32x4*)(vbase + (size_t)(r0_ + 64) * LDQ + spc * 8); } while (0)
#define BW_WRITE(buf_) do { LAS unsigned char* kb_ = lds + (buf_) * 2 * BST; LAS unsigned char* vb_ = kb_ + BST; \
        *(LAS u32x4*)(kb_ + srow * VROW + spc * 16) = kr[0]; *(LAS u32x4*)(kb_ + (srow + 64) * VROW + spc * 16) = kr[1]; \
        *(LAS u32x4*)(vb_ + srow * VROW + spc * 16) = vr[0]; *(LAS u32x4*)(vb_ + (srow + 64) * VROW + spc * 16) = vr[1]; } while (0)
    SoftState st; soft_init(st);
    unsigned rem = visw; int blk = rem ? (int)__builtin_ctz(rem) : own, half = 0;
    BW_LOAD(blk, 0); BW_WRITE(0);
    __syncthreads();
    for (int sidx = 0; sidx < nsteps; ++sidx) {
        int nblk = blk, nhalf = half ^ 1; unsigned nrem = rem;
        if (half == 1) { nrem = rem & (rem - 1u); nblk = nrem ? (int)__builtin_ctz(nrem) : own; }
        const bool has_next = (sidx + 1 < nsteps);
        if (has_next) BW_LOAD(nblk, nhalf);
        const LAS unsigned char* kst = lds + (sidx & 1) * 2 * BST; const LAS unsigned char* vst = kst + BST;
        if (blk == own) {
#pragma unroll 1
            for (int ch = 0; ch < 4; ++ch) { const int ci = 4 * half + ch;
                if (ci <= wid) soft_compute_lds(st, qf, kst + ch * 32 * VROW, vst + ch * 32 * VROW, 256 * blk + 32 * ci, qp, true, ci == wid, c); }
        } else if ((vis >> blk) & 1u) {
            const bool mine = ((sel >> blk) & 1u) != 0u;
#pragma unroll 1
            for (int ch = 0; ch < 4; ++ch) soft_compute_lds(st, qf, kst + ch * 32 * VROW, vst + ch * 32 * VROW, 256 * blk + 128 * half + 32 * ch, qp, mine, false, c);
        }
        if (has_next) BW_WRITE((sidx + 1) & 1);
        __syncthreads();
        blk = nblk; half = nhalf; rem = nrem;
    }
#undef BW_LOAD
#undef BW_WRITE
    store_o(st.o, __builtin_amdgcn_rcpf(st.l), outB + (size_t)(b * SEQ + qp) * 384 + hb * 64, c);
}
__device__ __forceinline__ void unit_C(const bf16_t* qkv, bf16_t* outC, int b, int hc, int qt, const WaveCtx& c) {
    const int qp = 32 * qt + c.q, head = 18 + hc;
    const bf16_t* rowb = qkv + (size_t)b * SEQ * LDQ;
    bf16x8 qf[4]; load_q(qf, rowb + (size_t)qp * LDQ + head * 64, c.h);
    const bf16_t* kbase = rowb + MIXW + head * 64; const bf16_t* vbase = rowb + 2 * MIXW + head * 64;
    f32x16 o[2];
#pragma unroll
    for (int r = 0; r < 16; ++r) { o[0][r] = 0.f; o[1][r] = 0.f; }
    float carry = 0.f;
    KV ta, tb;
    issue_kv<false>(ta, kbase, vbase, 32 * qt, 1, c);
    bool done = false;
#define C_STEP(T, ch) do { \
        const int k0 = 32 * (ch); \
        store_v(T.vr, c); VF vf; read_vf(vf, c); \
        f32x16 z = qk(T.kf, qf); \
        float lk[16], gs[4]; \
        const bool diag = ((ch) == qt); \
        _Pragma("unroll") for (int r = 0; r < 16; ++r) { \
            const bool ok = diag ? ((k0 + crow(r, c.h)) < qp) : true; \
            const float zz = z[r], sp = fmaxf(zz, 0.f) + __builtin_amdgcn_logf(1.0f + __builtin_amdgcn_exp2f(-fabsf(zz)));   \
            lk[r] = ok ? -sp : 0.f; \
            z[r] = ok ? (zz - sp) : -1e30f; } \
        _Pragma("unroll") for (int g4 = 0; g4 < 4; ++g4) gs[g4] = (lk[4 * g4] + lk[4 * g4 + 1]) + (lk[4 * g4 + 2] + lk[4 * g4 + 3]); \
        float os[4]; \
        _Pragma("unroll") for (int g4 = 0; g4 < 4; ++g4) os[g4] = xor32_get(gs[g4], c.h); \
        float T_ = 0.f; \
        _Pragma("unroll") for (int g4 = 3; g4 >= 0; --g4) { \
            const float base = carry + T_ + (c.h == 0 ? os[g4] : 0.f); \
            const float a3 = base, a2 = a3 + lk[4 * g4 + 3], a1 = a2 + lk[4 * g4 + 2], a0 = a1 + lk[4 * g4 + 1]; \
            z[4 * g4 + 3] = __builtin_amdgcn_exp2f(z[4 * g4 + 3] + a3); z[4 * g4 + 2] = __builtin_amdgcn_exp2f(z[4 * g4 + 2] + a2); \
            z[4 * g4 + 1] = __builtin_amdgcn_exp2f(z[4 * g4 + 1] + a1); z[4 * g4 + 0] = __builtin_amdgcn_exp2f(z[4 * g4 + 0] + a0); \
            T_ += gs[g4] + os[g4]; } \
        carry += T_; \
        pv(o, z, vf); \
        done = (__ballot(carry > -150.5f) == 0ull);   } while (0)
    for (int ch = qt; ch >= 0; ch -= 2) {
        if (ch > 0) issue_kv<false>(tb, kbase, vbase, 32 * (ch - 1), 1, c);
        C_STEP(ta, ch);
        if (done || ch == 0) break;
        if (ch > 1) issue_kv<false>(ta, kbase, vbase, 32 * (ch - 2), 1, c);
        C_STEP(tb, ch - 1);
        if (done) break;
    }
#undef C_STEP
    store_o(o, 1.0f, outC + (size_t)(b * SEQ + qp) * 384 + hc * 64, c);
}

__device__ __forceinline__ void attn_phase(const Params& p, unsigned char* ws, int layer, LAS unsigned char* lds, const int tid, int rep) {
    const int wid = __builtin_amdgcn_readfirstlane(tid >> 6);
    const bf16_t* qkv = (const bf16_t*)(ws + WS_QKV);
    const float* kmean = (const float*)(ws + WS_KMEAN);
    bf16_t* outA = (bf16_t*)(ws + WS_ATTA); bf16_t* outB = (bf16_t*)(ws + WS_ATTB); bf16_t* outC = (bf16_t*)(ws + WS_ATTC);
    const bool a_static = (gridDim.x == 256);
    if (a_static) {
        int t2 = tid; asm volatile("" : "+v"(t2));
        const int lane = t2 & 63;
        WaveCtx c; c.lane = lane; c.q = lane & 31; c.h = lane >> 5; c.vl = lds + wid * VTILE;
        { const int i = lane & 15, qq = i >> 2, pp = i & 3, blk = (lane >> 4) & 1; c.troff = (4 * c.h + qq) * VROW + (16 * blk + 4 * pp) * 2; }
        const int g8 = (int)blockIdx.x, jb = g8 >> 3;
        unit_A2(qkv, outA, g8 & 7, jb >> 3, jb & 7, wid, lds, c);
        __syncthreads();
    }
    for (int rb = 0; rb < REP_B; ++rb) {
        unsigned* ctrB = (unsigned*)(ws + WS_CTR) + 4096 + (layer * 2 + rb) * 64;
        LAS unsigned* qw = (LAS unsigned*)(lds + 131072 + 192);
        for (;;) {
            int t2 = tid; asm volatile("" : "+v"(t2));
            const int lane = t2 & 63;
            WaveCtx c; c.lane = lane; c.q = lane & 31; c.h = lane >> 5; c.vl = lds;
            { const int i = lane & 15, qq = i >> 2, pp = i & 3, blk = (lane >> 4) & 1; c.troff = (4 * c.h + qq) * VROW + (16 * blk + 4 * pp) * 2; }
            __syncthreads();
            if (t2 == 0) *qw = atomicAdd(ctrB, 1u);
            __syncthreads();
            const unsigned u = (unsigned)__builtin_amdgcn_readfirstlane((int)*qw);
            const unsigned ngu = (gridDim.x == 256) ? 128u : 0u;
            if (u >= 384u + ngu) break;
            if (u >= 192u && u < 192u + ngu) {
                pg8::StaticOrder so; so.init(M, NQKVG, 256, (int)(u - 192u));
                OneUnit S1; so.next(7, S1.u0);
                pg8::Gemm g{(const bf16_t*)(ws + WS_H), (const bf16_t*)(ws + WS_W + W_QKVG), M, NQKVG, DM};
                EpiQKVG E{(bf16_t*)(ws + WS_QKV), (bf16_t*)(ws + WS_GATES), p.b_gate + (size_t)layer * NG, (const float*)(ws + WS_COS), (const float*)(ws + WS_SIN), (float*)(ws + WS_KMEAN)};
                pg8::gemm_phase<EpiQKVG, OneUnit, false, GSP2>(lds, g, S1, E, t2);
                continue;
            }
            const unsigned ub = (u < 192u) ? u : u - ngu;
            const int qb = 7 - (int)(ub / 48u), r2 = (int)(ub % 48u);
            wg_unit_B(qkv, kmean, outB, r2 / 6, r2 % 6, qb, lds, wid, c, t2);
        }
        __syncthreads();
    }
    const int qid = blockIdx.x & 7;
    for (int rac = 0; rac < REP_AC; ++rac) {
    unsigned* ctr = (unsigned*)(ws + WS_CTR) + ((layer * 8 + qid) * 2 + rac) * 64;
    for (;;) {
        int t2 = tid; asm volatile("" : "+v"(t2));
        const int lane = t2 & 63;
        WaveCtx c; c.lane = lane; c.q = lane & 31; c.h = lane >> 5; c.vl = lds + wid * VTILE;
        { const int i = lane & 15, qq = i >> 2, pp = i & 3, blk = (lane >> 4) & 1; c.troff = (4 * c.h + qq) * VROW + (16 * blk + 4 * pp) * 2; }
        unsigned u = 0;
        if (lane == 0) u = atomicAdd(ctr, 1u);
        u = (unsigned)__builtin_amdgcn_readfirstlane((int)u);
        if (a_static) u += 256u;
        if (u >= 640u) break;
        const int wgu = (int)(u >> 3) * 8 + qid, sub = (int)(u & 7);
        if (wgu < 256) { unit_A(qkv, outA, wgu >> 5, (wgu & 31) >> 3, wgu & 7, sub, c); }
        else { const int w2 = wgu - 256, qb = 7 - w2 / 48, r2 = w2 % 48; unit_C(qkv, outC, r2 / 6, r2 % 6, qb * 8 + sub, c); }
    }
    }
}

__device__ __forceinline__ void phase0(const Params& p, LAS unsigned char* lds, const int tid) {
    const int lane = tid & 63, wid = tid >> 6;
    LAS float* cact = (LAS float*)lds;
    if (blockIdx.x == 0) { for (int i = tid; i < 4096 + DEPTH * 2 * 64; i += NTHR) ((unsigned*)(p.ws + WS_CTR))[i] = 0u; }
    {
        float* cosT = (float*)(p.ws + WS_COS); float* sinT = (float*)(p.ws + WS_SIN);
        for (int i = blockIdx.x * NTHR + tid; i < SEQ * 32; i += gridDim.x * NTHR) {
            const int pos = i >> 5, j = i & 31;
            const float inv = exp2f(-(float)j * 0.41524101186092029f);
            const float ang = (float)pos * inv;
            double a = (double)ang; const double twopi = 6.283185307179586476925;
            a -= twopi * rint(a / twopi);
            const double a2 = a * a;
            double cs = 1.0, term = 1.0, sn = a, ts = a;
#pragma unroll 1
            for (int k = 1; k <= 14; ++k) { term *= -a2 / (double)((2 * k - 1) * (2 * k)); cs += term; ts *= -a2 / (double)((2 * k) * (2 * k + 1)); sn += ts; }
            cosT[i] = (float)cs; sinT[i] = (float)sn;
        }
    }
    for (int i = blockIdx.x * NTHR + tid; i < 8 * 64 * 64; i += 256 * NTHR) { if (blockIdx.x < 256) ((unsigned*)(p.ws + WS_CNT))[i] = 0u; }
    for (int i = blockIdx.x * NTHR + tid; i < M * 16; i += 256 * NTHR) { if (blockIdx.x < 256) *(u32x4*)((bf16_t*)(p.ws + WS_ATTA) + (size_t)(i >> 4) * 384 + 256 + (i & 15) * 8) = (u32x4){0u, 0u, 0u, 0u}; }
    for (int i = tid; i < NB * DM; i += NTHR) { const float v = p.c[i]; cact[i] = v / (1.0f + __expf(-v)); }
    __syncthreads();
    float* mod = (float*)(p.ws + WS_MOD);
    LAS float* red2 = (LAS float*)(lds + 32768);
    const int hw = tid >> 5, cl = tid & 31;
    for (int unit = blockIdx.x; unit < DEPTH * 192; unit += gridDim.x) {
        const int l = unit / 192, n0 = (unit % 192) * 32;
        const float* W = p.w_ada + (size_t)l * DM * 6 * DM + (size_t)(hw * 64) * 6 * DM + n0 + cl;
        float a[8];
#pragma unroll
        for (int b = 0; b < 8; ++b) a[b] = 0.f;
#pragma unroll 1
        for (int kb = 0; kb < 64; kb += 16) {
            float w[16];
#pragma unroll
            for (int j = 0; j < 16; ++j) w[j] = W[(size_t)(kb + j) * 6 * DM];
#pragma unroll
            for (int j = 0; j < 16; ++j)
#pragma unroll
                for (int b = 0; b < 8; ++b) a[b] += cact[b * DM + hw * 64 + kb + j] * w[j];
        }
#pragma unroll
        for (int b = 0; b < 8; ++b) red2[(hw * 8 + b) * 32 + cl] = a[b];
        __syncthreads();
        if (tid < 256) {
            const int b = tid >> 5; float sum = 0.f;
#pragma unroll
            for (int h2 = 0; h2 < 16; ++h2) sum += red2[(h2 * 8 + b) * 32 + cl];
            mod[((size_t)l * NB + b) * 6 * DM + n0 + cl] = sum + p.b_ada[(size_t)l * 6 * DM + n0 + cl];
        }
        __syncthreads();
    }
}
__device__ __forceinline__ void norm_rows(const float* x, const float* g, const float* modl  , int sh_off, int sc_off, bf16_t* h, int gw, int ngw, int lane) {
    f32x4 gv[4];
#pragma unroll
    for (int j = 0; j < 4; ++j) gv[j] = *((const f32x4*)g + lane + 64 * j);
    for (int row = gw; row < M; row += ngw) {
        const f32x4* xr = (const f32x4*)(x + (size_t)row * DM) + lane;
        f32x4 v[4]; float ss = 0.f;
#pragma unroll
        for (int j = 0; j < 4; ++j) { v[j] = xr[64 * j]; ss += (v[j].x * v[j].x + v[j].y * v[j].y) + (v[j].z * v[j].z + v[j].w * v[j].w); }
        const float rstd = 1.0f / sqrtf(wave_sum(ss) * (1.0f / DM) + NORM_EPS);
        const float* mb = modl + (size_t)(row >> 11) * 6 * DM;
        unsigned long long* o8 = (unsigned long long*)(h + (size_t)row * DM) + lane;
#pragma unroll
        for (int j = 0; j < 4; ++j) {
            const f32x4 sc = *((const f32x4*)(mb + sc_off) + lane + 64 * j), sh = *((const f32x4*)(mb + sh_off) + lane + 64 * j);
            const f32x4 y = v[j] * rstd * gv[j] * (sc + 1.0f) + sh;
            o8[64 * j] = (unsigned long long)pk2(y.x, y.y) | ((unsigned long long)pk2(y.z, y.w) << 32);
        }
    }
}
__device__ __forceinline__ void final_norm(float* x, const float* g, int gw, int ngw, int lane) {
    f32x4 gv[4];
#pragma unroll
    for (int j = 0; j < 4; ++j) gv[j] = *((const f32x4*)g + lane + 64 * j);
    for (int row = gw; row < M; row += ngw) {
        f32x4* xr = (f32x4*)(x + (size_t)row * DM) + lane;
        f32x4 v[4]; float ss = 0.f;
#pragma unroll
        for (int j = 0; j < 4; ++j) { v[j] = xr[64 * j]; ss += (v[j].x * v[j].x + v[j].y * v[j].y) + (v[j].z * v[j].z + v[j].w * v[j].w); }
        const float rstd = 1.0f / sqrtf(wave_sum(ss) * (1.0f / DM) + NORM_EPS);
#pragma unroll
        for (int j = 0; j < 4; ++j) xr[64 * j] = v[j] * rstd * gv[j];
    }
}
__device__ __forceinline__ void convert_weights(const Params& p, unsigned char* ws, int l, LAS unsigned char* lds, int gw, int ngw, int wid, int lane) {
    LAS float* scr = (LAS float*)(lds + wid * 16384);
    unsigned char* wb = ws + WS_W;
    constexpr int I_IN = 16 * 144, I_G = 16 * 96, I_A = 4 * 32, I_B = 6 * 32, I_O = 16 * 32, I_GU = 16 * 176, I_D = 44 * 32;
    constexpr int NIT = I_IN + I_G + I_A + 2 * I_B + I_O + I_GU + I_D;
    for (int it = gw; it < NIT; it += ngw) {
        int r = it;
        if (r < I_IN) { transpose_item(p.w_in + (size_t)l * DM * LDQ, DM, LDQ, (bf16_t*)(wb + W_QKVG), DM, 0, 1, scr, r, lane); continue; } r -= I_IN;
        if (r < I_G) { transpose_item(p.w_gate + (size_t)l * DM * NG, DM, NG, (bf16_t*)(wb + W_QKVG), DM, LDQ, 0, scr, r, lane); continue; } r -= I_G;
        if (r < I_A) { transpose_item(p.w_br_a + (size_t)l * 256 * DM, 256, DM, (bf16_t*)(wb + W_A), 384, 0, 0, scr, r, lane); continue; } r -= I_A;
        if (r < I_B) { transpose_item(p.w_br_b + (size_t)l * 384 * DM, 384, DM, (bf16_t*)(wb + W_B), 384, 0, 0, scr, r, lane); continue; } r -= I_B;
        if (r < I_B) { transpose_item(p.w_br_c + (size_t)l * 384 * DM, 384, DM, (bf16_t*)(wb + W_C), 384, 0, 0, scr, r, lane); continue; } r -= I_B;
        if (r < I_O) { transpose_item(p.w_out + (size_t)l * DM * DM, DM, DM, (bf16_t*)(wb + W_O), DM, 0, 0, scr, r, lane); continue; } r -= I_O;
        if (r < I_GU) { transpose_item(p.w_gu + (size_t)l * DM * NGU, DM, NGU, (bf16_t*)(wb + W_GU), DM, 0, 2, scr, r, lane); continue; } r -= I_GU;
        transpose_item(p.w_down + (size_t)l * DFF * DM, DFF, DM, (bf16_t*)(wb + W_D), DFF, 0, 0, scr, r, lane);
    }
    { unsigned z = 0u; asm volatile("" : "+v"(z));
      for (int r = gw; r < DM; r += ngw) { if (lane < 16) *(u32x4*)((bf16_t*)(wb + W_A) + (size_t)r * 384 + 256 + lane * 8) = (u32x4){z, z, z, z}; } }
}

constexpr int PPL = 7;
constexpr int N_PHASES = 1 + PPL * DEPTH;
__global__ void __launch_bounds__(NTHR, 2) fwd_kernel(Params p) {
    extern __shared__ __attribute__((aligned(16))) unsigned char lds_raw[];
    LAS unsigned char* lds = (LAS unsigned char*)lds_raw;
    const int G = gridDim.x, ngw = G * NWAVES;
    volatile LAS unsigned* bst = (volatile LAS unsigned*)(lds + 131072 + 64);
    if (threadIdx.x < 2) bst[threadIdx.x] = 0u;
    __syncthreads();
    (void)xcd_barrier_post((unsigned*)(p.ws + WS_BAR), bst);
    if (p.ph_lo == 0) {
        int tid = threadIdx.x; asm volatile("" : "+v"(tid));
        for (int rep = 0; rep < REP_P0; ++rep) { phase0(p, lds, tid); __syncthreads(); }
        if (p.ph_hi > 1) xcd_barrier((unsigned*)(p.ws + WS_BAR), (volatile LAS unsigned*)(lds + 131072 + 64), tid);
        if (p.ph_hi < 0) cg::this_grid().sync();
    }
    const int ph_a = p.ph_lo < 1 ? 1 : p.ph_lo, ph_b = p.ph_hi;
    const int wid_s = __builtin_amdgcn_readfirstlane((int)(threadIdx.x >> 6));
    for (int ph = ph_a; ph < ph_b; ++ph) {
        unsigned ones = ~0u; asm volatile("" : "+s"(ones));
        int tid = wid_s * 64 + (int)__builtin_amdgcn_mbcnt_hi(ones, __builtin_amdgcn_mbcnt_lo(ones, 0u)); asm volatile("" : "+v"(tid));
        unsigned char* ws = p.ws; asm volatile("" : "+s"(ws));
        float* mod = (float*)(ws + WS_MOD);
        bf16_t* H = (bf16_t*)(ws + WS_H); bf16_t* QKV = (bf16_t*)(ws + WS_QKV); bf16_t* GATES = (bf16_t*)(ws + WS_GATES);
        bf16_t* MERGED = (bf16_t*)(ws + WS_MERGED); bf16_t* ACT = (bf16_t*)(ws + WS_QKV);
        unsigned char* wb = ws + WS_W;
        {
            const int l = (ph - 1) / PPL, k = (ph - 1) % PPL;
            const float* modl = mod + (size_t)l * NB * 6 * DM;
            const float* xin = (l == 0) ? p.x : p.out;
            switch (k) {
#if PHEN(0)
            case 0: {
                float* km = (float*)(ws + WS_KMEAN);
                if (blockIdx.x == 0) { for (int i = tid; i < NB * 6 * 8 * 64; i += NTHR) km[i] = 0.f; }
                const int lane = tid & 63, wid = __builtin_amdgcn_readfirstlane(tid >> 6), gw = blockIdx.x * NWAVES + wid;
                convert_weights(p, ws, l, lds, gw, ngw, wid, lane);
                if (l == 0) norm_rows(p.x, p.norm1_g, modl, 0, DM, H, gw, ngw, lane);
            } break;
#endif
#if PHEN(1)
            case 1: {
                pg8::Gemm g{H, (const bf16_t*)(wb + W_QKVG), M, NQKVG, DM}; LimitOrder S; S.base.init(M, NQKVG, G, (int)blockIdx.x); S.lim = (G == 256) ? 7 : 1000;
                EpiQKVG E{QKV, GATES, p.b_gate + (size_t)l * NG, (const float*)(ws + WS_COS), (const float*)(ws + WS_SIN), (float*)(ws + WS_KMEAN)};
                pg8::gemm_phase<EpiQKVG, LimitOrder, GALIGN, GSP2>(lds, g, S, E, tid);
            } break;
#endif
#if PHEN(2)
            case 2: for (int rep = 0; rep < REP_ATT; ++rep) { attn_phase(p, ws, l, lds, tid, rep); __syncthreads(); } break;
#endif
#if PHEN(3)
            case 3: {
                pg8::Gemm g{(const bf16_t*)(ws + WS_ATTA), (const bf16_t*)(wb + W_A), 3 * M, 3 * DM, 384};
                BranchOrder S; S.base.init(M, DM, G, (int)blockIdx.x);
                EpiBranch E{GATES, MERGED};
                pg8::gemm_phase<EpiBranch, BranchOrder, GALIGN, GSP2>(lds, g, S, E, tid);
            } break;
#endif
#if PHEN(4)
            case 4: {
                pg8::Gemm g{MERGED, (const bf16_t*)(wb + W_O), M, DM, DM}; pg8::StaticOrder S; S.init(M, DM, G, (int)blockIdx.x);
                RowStats rs{(unsigned*)(ws + WS_XBUF), (unsigned*)(ws + WS_CNT) + (size_t)(2 * l) * 64 * 64};
                EpiResidNorm E{l == 0 ? p.x : nullptr, (const bf16_t*)(ws + WS_X16), (bf16_t*)(ws + WS_GATES), nullptr, modl + 2 * DM, H, p.norm2_g + (size_t)l * DM, modl + 4 * DM, modl + 3 * DM, rs, 0};
                pg8::gemm_phase<EpiResidNorm, pg8::StaticOrder, false, GSP2>(lds, g, S, E, tid);
            } break;
#endif
#if PHEN(6)
            case 5: {
                pg8::Gemm g{H, (const bf16_t*)(wb + W_GU), M, NGU, DM}; pg8::StaticOrder S; S.init(M, NGU, G, (int)blockIdx.x);
                EpiSwiGLU E{ACT};
                pg8::gemm_phase<EpiSwiGLU, pg8::StaticOrder, GALIGN, GSP2>(lds, g, S, E, tid);
            } break;
#endif
#if PHEN(7)
            case 6: {
                pg8::Gemm g{ACT, (const bf16_t*)(wb + W_D), M, DM, DFF}; pg8::StaticOrder S; S.init(M, DM, G, (int)blockIdx.x);
                RowStats rs{(unsigned*)(ws + WS_XBUF), (unsigned*)(ws + WS_CNT) + (size_t)(2 * l + 1) * 64 * 64};
                const bool fin = (l == DEPTH - 1);
                const float* modn = mod + (size_t)(fin ? l : l + 1) * NB * 6 * DM;
                EpiResidNorm E{nullptr, (const bf16_t*)(ws + WS_GATES), (bf16_t*)(ws + WS_X16), p.out, modl + 5 * DM, H, fin ? p.final_g : p.norm1_g + (size_t)(l + 1) * DM, modn + DM, modn, rs, fin ? 1 : 0};
                pg8::gemm_phase<EpiResidNorm, pg8::StaticOrder, false, GSP2>(lds, g, S, E, tid);
            } break;
#endif
            default: break;
            }
        }
        if (ph + 1 < p.ph_hi) { for (int rep = 0; rep < REP_SYNC; ++rep) xcd_barrier((unsigned*)(ws + WS_BAR), (volatile LAS unsigned*)(lds + 131072 + 64), tid); }
    }
}

extern "C" void kernel_launch(void* const* d_in, const int* in_sizes, int n_in, void* d_out, int out_size, void* d_ws, size_t ws_size, hipStream_t stream) {
    static int grid = 0;
    if (grid == 0) {
        if (n_in != 16 || out_size != M * DM || ws_size < WS_END) { fprintf(stderr, "kernel_launch: unexpected sizes n_in %d out %d ws %zu\n", n_in, out_size, ws_size); grid = -1; return; }
        int dev = 0, cus = 0, per_cu = 0;
        if (hipGetDevice(&dev) != hipSuccess || hipDeviceGetAttribute(&cus, hipDeviceAttributeMultiprocessorCount, dev) != hipSuccess) { grid = -1; return; }
        if (hipFuncSetAttribute((const void*)fwd_kernel, hipFuncAttributeMaxDynamicSharedMemorySize, LDS_BYTES) != hipSuccess) { fprintf(stderr, "kernel_launch: hipFuncSetAttribute failed\n"); grid = -1; return; }
        if (hipOccupancyMaxActiveBlocksPerMultiprocessor(&per_cu, (const void*)fwd_kernel, NTHR, LDS_BYTES) != hipSuccess || per_cu < 1) { fprintf(stderr, "kernel_launch: occupancy query says %d\n", per_cu); per_cu = 1; }
        (void)hipGetLastError();
        grid = cus * 1;
    }
    if (grid < 0) return;
    if (hipMemsetAsync((char*)d_ws + WS_BAR, 0, XCD_BAR_WORDS * 4, stream) != hipSuccess) { fprintf(stderr, "kernel_launch: memset failed\n"); return; }
    Params p{};
    p.x = (const float*)d_in[0]; p.c = (const float*)d_in[1]; p.w_ada = (const float*)d_in[2]; p.b_ada = (const float*)d_in[3]; p.norm1_g = (const float*)d_in[4];
    p.w_in = (const float*)d_in[5]; p.w_br_a = (const float*)d_in[6]; p.w_br_b = (const float*)d_in[7]; p.w_br_c = (const float*)d_in[8]; p.w_gate = (const float*)d_in[9];
    p.b_gate = (const float*)d_in[10]; p.w_out = (const float*)d_in[11]; p.norm2_g = (const float*)d_in[12]; p.w_gu = (const float*)d_in[13]; p.w_down = (const float*)d_in[14];
    p.final_g = (const float*)d_in[15];
    p.out = (float*)d_out; p.ws = (unsigned char*)d_ws;
#if MK_MULTI_LAUNCH
    for (int ph = 0; ph < N_PHASES; ++ph) {
        p.ph_lo = ph; p.ph_hi = ph + 1;
        hipLaunchKernelGGL(fwd_kernel, dim3(grid), dim3(NTHR), LDS_BYTES, stream, p);
    }
#else
    p.ph_lo = 0; p.ph_hi = N_PHASES;
    void* args[] = {&p};
    hipError_t e = hipLaunchCooperativeKernel((const void*)fwd_kernel, dim3(grid), dim3(NTHR), args, LDS_BYTES, stream);
    if (e != hipSuccess) fprintf(stderr, "cooperative launch failed: %s (grid %d)\n", hipGetErrorString(e), grid);
#endif
}
```

```cpp
#include <hip/hip_runtime.h>
#include <hip/hip_cooperative_groups.h>
#include <cstdio>
#include <cstdint>
namespace cg = cooperative_groups;

#ifndef PHMASK
#define PHMASK 0xff
#endif
#define PHEN(k) ((PHMASK >> (k)) & 1)
#ifndef REPK
#define REPK -1
#endif
#ifndef REP_P0
#define REP_P0 1
#endif
#ifndef REP_B
#define REP_B 1
#endif
#ifndef REP_AC
#define REP_AC 1
#endif
#ifndef REP_ATT
#define REP_ATT 1
#endif
#ifndef REP_GU
#define REP_GU 1
#endif
#ifndef REP_SYNC
#define REP_SYNC 1
#endif
#ifndef REP_NORM
#define REP_NORM 1
#endif
#ifndef GALIGN
#define GALIGN true
#endif
#ifndef GSP2
#define GSP2 true
#endif
#ifndef MK_MULTI_LAUNCH
#define MK_MULTI_LAUNCH 0
#endif

namespace pg8 {
#define PG8_LAS __attribute__((address_space(3)))
typedef unsigned short bf16_t;
typedef short bf16x8 __attribute__((ext_vector_type(8)));
typedef float f32x4 __attribute__((ext_vector_type(4)));
typedef unsigned u32x4 __attribute__((ext_vector_type(4)));
constexpr int BM = 256, BK = 64, HALF = 128, HTB = HALF * BK * 2  , STAGE_BYTES = 8 * HTB, NXCD = 8, WGM = 8;

__host__ __device__ __forceinline__ int lds_byte(int r, int c) { const int st = (r >> 4) * 2 + (c >> 5), rr = r & 15, cc = c & 31, ob = rr * 64 + cc * 2; return st * 1024 + (ob ^ (((ob >> 9) & 1) << 5)); }
__host__ __device__ __forceinline__ void stage_rc(int b, int& R, int& C) { const int st = b / 1024, sb = b % 1024, swz = sb ^ (((sb >> 9) & 1) << 5); R = (st >> 1) * 16 + swz / 64; C = (st & 1) * 32 + (swz % 64) / 2; }
__host__ __device__ __forceinline__ int perm32(int rho) { const int n = rho >> 4, i = rho & 15; return 8 * (i >> 2) + 4 * n + (i & 3); }

struct Unit { int pm, pn; };
struct Gemm { const bf16_t* A; const bf16_t* Bt; int M, N, K; };

struct StaticOrder {
    int nM, nN, nwg, G, c;
    __host__ __device__ void init(int M, int N, int G_, int c_) { nM = M / BM; nN = N / BM; nwg = nM * nN; G = G_; c = c_; }
    __host__ __device__ bool next(int i, Unit& u) const {
        const long L = (long)i * G + c; if (L >= nwg) return false;
        int wgid = (int)L; { const int q = nwg / NXCD, r = nwg % NXCD, xcd = wgid % NXCD, off = wgid / NXCD; wgid = (xcd < r ? xcd * (q + 1) : r * (q + 1) + (xcd - r) * q) + off; }
        const int nig = WGM * nN, gid = wgid / nig, fm = gid * WGM, gsz = (nM - fm) < WGM ? (nM - fm) : WGM;
        u.pm = fm + ((wgid % nig) % gsz); u.pn = (wgid % nig) / gsz; return true;
    }
    __device__ __forceinline__ void a_ready(const Unit&) const {}
    __device__ __forceinline__ void done(const Unit&) const {}
};

__device__ __forceinline__ unsigned cvt_pk_bf16(float lo, float hi) { unsigned r; asm volatile("v_cvt_pk_bf16_f32 %0, %1, %2" : "=v"(r) : "v"(lo), "v"(hi)); return r; }

template <class Epi, class Sched, bool ALIGN_EPI = false, bool SP2 = false>
__device__ __forceinline__ void gemm_phase(PG8_LAS unsigned char* lds, const Gemm g, const Sched& S, const Epi& E, const int tid) {
    const int wid = __builtin_amdgcn_readfirstlane(tid >> 6), lane = tid & 63, wr = wid >> 2, wc = wid & 3, fr = lane & 15, fq = lane >> 4;
    const int K = g.K, nt = K / BK;
    unsigned voffA[2], voffB[2];
#pragma unroll
    for (int i = 0; i < 2; ++i) { int R, C; stage_rc(tid * 16 + i * 8192, R, C); const int Rb = Epi::PERM ? ((R & ~31) + perm32(R & 31)) : R;
        voffA[i] = (unsigned)(R * K + C) * 2u; voffB[i] = (unsigned)(Rb * K + C) * 2u; }
    const size_t kstep = (size_t)(BK * 2);
    const size_t hstep = (size_t)HALF * K * 2;
    const size_t tstep = 2 * hstep;
    const unsigned ldsw = (unsigned)wid * 1024u;
    const int aoff = lds_byte(wr * 64 + fr, fq * 8), boff = lds_byte(wc * 32 + fr, fq * 8);
#define PG8_SA(b, h) (((b) * 2 + (h)) * HTB)
#define PG8_SB(b, h) ((4 + (b) * 2 + (h)) * HTB)
#define PG8_STAGE(bufoff, gbase, voff) do { _Pragma("unroll") for (int _i = 0; _i < 2; ++_i) \
        __builtin_amdgcn_global_load_lds((const unsigned*)((const char*)(gbase) + (voff)[_i]), (PG8_LAS unsigned*)(lds + (bufoff) + ldsw + _i * 8192), 16, 0, 0); } while (0)
#define PG8_LDA(dst, b, h) do { _Pragma("unroll") for (int m = 0; m < 4; ++m) _Pragma("unroll") for (int k = 0; k < 2; ++k) dst[m][k] = *(const PG8_LAS bf16x8*)(lds + PG8_SA(b, h) + aoff + m * 2048 + k * 1024); } while (0)
#define PG8_LDB(dst, b, h) do { _Pragma("unroll") for (int n = 0; n < 2; ++n) _Pragma("unroll") for (int k = 0; k < 2; ++k) dst[n][k] = *(const PG8_LAS bf16x8*)(lds + PG8_SB(b, h) + boff + n * 2048 + k * 1024); } while (0)
#define PG8_MMA(ai, bj, At, Bt) do { __builtin_amdgcn_s_setprio(1); _Pragma("unroll") for (int m = 0; m < 4; ++m) _Pragma("unroll") for (int n = 0; n < 2; ++n) _Pragma("unroll") for (int k = 0; k < 2; ++k) \
        acc[ai][bj][m][n] = __builtin_amdgcn_mfma_f32_16x16x32_bf16(Bt[n][k], At[m][k], acc[ai][bj][m][n], 0, 0, 0); __builtin_amdgcn_s_setprio(0); } while (0)
#define PG8_WAIT_V(n) asm volatile("s_waitcnt vmcnt(" #n ")" ::: "memory")
#define PG8_WAIT_L(n) asm volatile("s_waitcnt lgkmcnt(" #n ")" ::: "memory")
#define PG8_BAR __builtin_amdgcn_s_barrier()
#define PG8_SCHED __builtin_amdgcn_sched_barrier(0)
    Unit cur, nxt; int ui = 0;
    if (!S.next(0, cur)) return;
    f32x4 acc[2][2][4][2];
#pragma unroll
    for (int a = 0; a < 2; ++a)
#pragma unroll
        for (int b = 0; b < 2; ++b)
#pragma unroll
            for (int m = 0; m < 4; ++m)
#pragma unroll
                for (int n = 0; n < 2; ++n) acc[a][b][m][n] = (f32x4){0.f, 0.f, 0.f, 0.f};
    bf16x8 At[4][2], B0[2][2], B1[2][2];
    const char* cA = (const char*)g.A + (size_t)cur.pm * tstep; const char* cB = (const char*)g.Bt + (size_t)cur.pn * tstep;
    S.a_ready(cur);
    if constexpr (SP2) {
        PG8_STAGE(PG8_SB(0, 0), cB, voffB); PG8_STAGE(PG8_SB(0, 1), cB + hstep, voffB); PG8_STAGE(PG8_SA(0, 0), cA, voffA); PG8_STAGE(PG8_SA(0, 1), cA + hstep, voffA);
        if (wr == 1) PG8_BAR;
        PG8_WAIT_V(2); PG8_BAR;
        PG8_STAGE(PG8_SB(1, 0), cB + kstep, voffB); PG8_STAGE(PG8_SA(1, 0), cA + kstep, voffA); PG8_STAGE(PG8_SB(1, 1), cB + hstep + kstep, voffB);
        PG8_WAIT_V(6); PG8_BAR;
    } else {
        PG8_STAGE(PG8_SB(0, 0), cB, voffB); PG8_STAGE(PG8_SA(0, 0), cA, voffA); PG8_STAGE(PG8_SB(0, 1), cB + hstep, voffB); PG8_STAGE(PG8_SA(0, 1), cA + hstep, voffA);
        if (wr == 1) PG8_BAR;
        PG8_WAIT_V(4); PG8_BAR;
        PG8_STAGE(PG8_SB(1, 0), cB + kstep, voffB); PG8_STAGE(PG8_SA(1, 0), cA + kstep, voffA); PG8_STAGE(PG8_SB(1, 1), cB + hstep + kstep, voffB);
        PG8_WAIT_V(6); PG8_BAR;
    }
    for (;;) {
        const bool has_next = S.next(ui + 1, nxt);
        const char* nA = has_next ? (const char*)g.A + (size_t)nxt.pm * tstep : cA; const char* nB = has_next ? (const char*)g.Bt + (size_t)nxt.pn * tstep : cB;
        for (int t = 0; t < nt; t += 2) {
            const bool last = (t == nt - 2);
            const char* a1 = cA + (size_t)(t + 1) * kstep;
            const char* a2 = last ? nA : cA + (size_t)(t + 2) * kstep; const char* b2 = last ? nB : cB + (size_t)(t + 2) * kstep;
            const char* a3 = a2 + kstep; const char* b3 = b2 + kstep;
            if (last && has_next) S.a_ready(nxt);
            if constexpr (SP2) {
            PG8_LDB(B0, 0, 0); PG8_LDB(B1, 0, 1); PG8_SCHED; PG8_LDA(At, 0, 0); PG8_STAGE(PG8_SA(1, 1), a1 + hstep, voffA);
            PG8_WAIT_V(8); PG8_WAIT_L(0); PG8_BAR; PG8_MMA(0, 0, At, B0); PG8_MMA(0, 1, At, B1); PG8_BAR; PG8_SCHED;
            PG8_LDA(At, 0, 1); PG8_STAGE(PG8_SB(0, 0), b2, voffB); PG8_STAGE(PG8_SB(0, 1), b2 + hstep, voffB); PG8_STAGE(PG8_SA(0, 0), a2, voffA);
            PG8_WAIT_V(8); PG8_WAIT_L(0); PG8_BAR; PG8_MMA(1, 0, At, B0); PG8_MMA(1, 1, At, B1); PG8_BAR; PG8_SCHED;
            PG8_LDB(B0, 1, 0); PG8_LDB(B1, 1, 1); PG8_SCHED; PG8_LDA(At, 1, 0); PG8_STAGE(PG8_SA(0, 1), a2 + hstep, voffA);
            PG8_WAIT_V(8); PG8_WAIT_L(0); PG8_BAR; PG8_MMA(0, 0, At, B0); PG8_MMA(0, 1, At, B1); PG8_BAR; PG8_SCHED;
            PG8_LDA(At, 1, 1); PG8_STAGE(PG8_SB(1, 0), b3, voffB); PG8_STAGE(PG8_SB(1, 1), b3 + hstep, voffB); PG8_STAGE(PG8_SA(1, 0), a3, voffA);
            PG8_WAIT_V(8); PG8_WAIT_L(0); PG8_BAR; PG8_MMA(1, 0, At, B0); PG8_MMA(1, 1, At, B1); PG8_BAR; PG8_SCHED;
            } else {
            PG8_LDB(B0, 0, 0); PG8_SCHED; PG8_LDA(At, 0, 0); PG8_STAGE(PG8_SA(1, 1), a1 + hstep, voffA);
            PG8_WAIT_L(8); PG8_BAR; PG8_WAIT_L(0); PG8_MMA(0, 0, At, B0); PG8_BAR; PG8_SCHED;
            PG8_LDB(B1, 0, 1); PG8_STAGE(PG8_SB(0, 0), b2, voffB);
            PG8_BAR; PG8_WAIT_L(0); PG8_MMA(0, 1, At, B1); PG8_BAR;
            PG8_LDA(At, 0, 1); PG8_STAGE(PG8_SA(0, 0), a2, voffA);
            PG8_BAR; PG8_WAIT_L(0); PG8_MMA(1, 0, At, B0); PG8_BAR; PG8_SCHED;
            PG8_STAGE(PG8_SB(0, 1), b2 + hstep, voffB);
            PG8_WAIT_V(6); PG8_BAR; PG8_MMA(1, 1, At, B1); PG8_BAR;
            PG8_LDB(B0, 1, 0); PG8_SCHED; PG8_LDA(At, 1, 0); PG8_STAGE(PG8_SA(0, 1), a2 + hstep, voffA);
            PG8_WAIT_L(8); PG8_BAR; PG8_WAIT_L(0); PG8_MMA(0, 0, At, B0); PG8_BAR; PG8_SCHED;
            PG8_LDB(B1, 1, 1); PG8_STAGE(PG8_SB(1, 0), b3, voffB);
            PG8_BAR; PG8_WAIT_L(0); PG8_MMA(0, 1, At, B1); PG8_BAR;
            PG8_LDA(At, 1, 1); PG8_STAGE(PG8_SA(1, 0), a3, voffA);
            PG8_BAR; PG8_WAIT_L(0); PG8_MMA(1, 0, At, B0); PG8_BAR; PG8_SCHED;
            PG8_STAGE(PG8_SB(1, 1), b3 + hstep, voffB);
            PG8_WAIT_V(6); PG8_BAR; PG8_MMA(1, 1, At, B1); PG8_BAR;
            }
        }
        if constexpr (ALIGN_EPI) { if (wr == 0) PG8_BAR; }
        if constexpr (!Epi::AFTER_DRAIN) { E(acc, cur, wr, wc, fr, fq); S.done(cur); }
        if (!has_next) break;
#pragma unroll
        for (int a = 0; a < 2; ++a)
#pragma unroll
            for (int b = 0; b < 2; ++b)
#pragma unroll
                for (int m = 0; m < 4; ++m)
#pragma unroll
                    for (int n = 0; n < 2; ++n) acc[a][b][m][n] = (f32x4){0.f, 0.f, 0.f, 0.f};
        cur = nxt; cA = nA; cB = nB; ++ui;
        if constexpr (ALIGN_EPI) { if (wr == 1) PG8_BAR; }
    }
    PG8_WAIT_V(0);
    if constexpr (!ALIGN_EPI) { if (wr == 0) PG8_BAR; }
    PG8_BAR;
    if constexpr (Epi::AFTER_DRAIN) { E.fused(acc, cur, wr, wc, fr, fq, lds, wid, lane); S.done(cur); }
#undef PG8_SA
#undef PG8_SB
#undef PG8_STAGE
#undef PG8_LDA
#undef PG8_LDB
#undef PG8_MMA
#undef PG8_WAIT_V
#undef PG8_WAIT_L
#undef PG8_BAR
#undef PG8_SCHED
}
}

#define LAS __attribute__((address_space(3)))
using pg8::bf16_t; using pg8::f32x4; using pg8::u32x4; using pg8::Unit;
typedef short bf16x8 __attribute__((ext_vector_type(8)));
typedef short s16x4 __attribute__((ext_vector_type(4)));
typedef short v4i16_t __attribute__((ext_vector_type(4)));
typedef float f32x16 __attribute__((ext_vector_type(16)));
typedef unsigned u32x2 __attribute__((ext_vector_type(2)));
typedef float f32x2_t __attribute__((ext_vector_type(2))); typedef __bf16 bf16x2_t __attribute__((ext_vector_type(2)));

constexpr int NWAVES = 8, NTHR = 512;
constexpr int DM = 1024, NB = 8, SEQ = 2048, DEPTH = 4, M = NB * SEQ;
constexpr int NHEAD = 24, MIXW = 1536, LDQ = 3 * MIXW  , NG = 3 * DM  , NQKVG = LDQ + NG  ;
constexpr int DFF = 2816, NGU = 2 * DFF;
constexpr float NORM_EPS = 1e-6f;
constexpr int LDS_BYTES = 147456;

constexpr size_t MiB = 1u << 20;
constexpr size_t WS_CTR = 0;
constexpr size_t WS_BAR = 32 * 1024;
constexpr size_t WS_MOD = 64 * 1024;
constexpr size_t WS_COS = WS_MOD + (size_t)DEPTH * NB * 6 * DM * 4;
constexpr size_t WS_SIN = WS_COS + (size_t)SEQ * 32 * 4;
constexpr size_t WS_KMEAN = WS_SIN + (size_t)SEQ * 32 * 4;
constexpr size_t WS_CNT = 2 * MiB;
constexpr size_t WS_XBUF = 2 * MiB + 256 * 1024;
constexpr size_t WS_W = 4 * MiB;
constexpr size_t W_QKVG = 0, W_A = W_QKVG + (size_t)NQKVG * DM * 2, W_B = W_A + (size_t)DM * 384 * 2, W_C = W_B + (size_t)DM * 384 * 2,
                 W_O = W_C + (size_t)DM * 384 * 2, W_GU = W_O + (size_t)DM * DM * 2, W_D = W_GU + (size_t)NGU * DM * 2, W_END = W_D + (size_t)DM * DFF * 2;
static_assert(W_END <= 40 * MiB, "weights");
constexpr size_t WS_H = 44 * MiB;
constexpr size_t WS_QKV = 76 * MiB;
constexpr size_t WS_GATES = 220 * MiB;
constexpr size_t WS_ATTA = 316 * MiB;
constexpr size_t WS_ATTB = WS_ATTA + (size_t)M * 384 * 2;
constexpr size_t WS_ATTC = WS_ATTB + (size_t)M * 384 * 2;
constexpr size_t WS_MERGED = 352 * MiB;
constexpr size_t WS_X16 = 384 * MiB;
constexpr size_t WS_END = 416 * MiB;

struct Params {
    const float *x, *c, *w_ada, *b_ada, *norm1_g, *w_in, *w_br_a, *w_br_b, *w_br_c, *w_gate, *b_gate, *w_out, *norm2_g, *w_gu, *w_down, *final_g;
    float* out; unsigned char* ws; int ph_lo, ph_hi;
};

__device__ __forceinline__ unsigned f2bf(float f) { unsigned u = __builtin_bit_cast(unsigned, f); return (u + 0x7fffu + ((u >> 16) & 1u)) >> 16; }
__device__ __forceinline__ unsigned pk2(float lo, float hi) { f32x2_t v = {lo, hi}; bf16x2_t b = __builtin_convertvector(v, bf16x2_t); return __builtin_bit_cast(unsigned, b); }
__device__ __forceinline__ float bf2f(unsigned short b) { return __uint_as_float((unsigned)b << 16); }
__device__ __forceinline__ float bflo(unsigned w) { return __uint_as_float(w << 16); }
__device__ __forceinline__ float bfhi(unsigned w) { return __uint_as_float(w & 0xffff0000u); }

template <int K> __device__ __forceinline__ float swz_xor(float v) { return __int_as_float(__builtin_amdgcn_ds_swizzle(__float_as_int(v), (K << 10) | 0x1f)); }
__device__ __forceinline__ float xor32_sum(float v) { auto rr = __builtin_amdgcn_permlane32_swap(__float_as_uint(v), __float_as_uint(v), false, false); return __uint_as_float(rr[0]) + __uint_as_float(rr[1]); }
__device__ __forceinline__ float xor32_max(float v) { auto rr = __builtin_amdgcn_permlane32_swap(__float_as_uint(v), __float_as_uint(v), false, false); return fmaxf(__uint_as_float(rr[0]), __uint_as_float(rr[1])); }
__device__ __forceinline__ float xor32_get(float v, int h) { auto rr = __builtin_amdgcn_permlane32_swap(__float_as_uint(v), __float_as_uint(v), false, false); return h == 0 ? __uint_as_float(rr[1]) : __uint_as_float(rr[0]); }
__device__ __forceinline__ float wave_sum(float v) {
    v += swz_xor<1>(v); v += swz_xor<2>(v); v += swz_xor<4>(v); v += swz_xor<8>(v); v += swz_xor<16>(v);
    return xor32_sum(v);
}
__device__ __forceinline__ float sigmoidf_(float x) { return __builtin_amdgcn_rcpf(1.0f + __expf(-x)); }


#define XB_TMO      128
#define XB_XCNT(j)  (256  + 64 * (j))
#define XB_XSUB(j)  (1280 + 64 * (j))
#define XB_XGEN(j)  (2304 + 64 * (j))
#define XB_TOP      3328
#define XB_TOPGEN   3392
#define XCD_BAR_WORDS 3456
#define XB_SPIN_CAP (1u << 22)
__device__ __forceinline__ unsigned xb_ld(unsigned* p)              { return __hip_atomic_load(p, __ATOMIC_RELAXED, __HIP_MEMORY_SCOPE_AGENT); }
__device__ __forceinline__ unsigned xb_add(unsigned* p, unsigned v) { return __hip_atomic_fetch_add(p, v, __ATOMIC_RELAXED, __HIP_MEMORY_SCOPE_AGENT); }
__device__ __forceinline__ unsigned xb_xcc_id() { return (unsigned)__builtin_amdgcn_s_getreg((3 << 11) | 20) & 0xFu; }
#define XB_SPIN(cond, bar) do { unsigned _sp = 0; while (cond) { __builtin_amdgcn_s_sleep(1); \
    if ((++_sp & 255u) == 0u) { if (xb_ld(&(bar)[XB_TMO])) break; if (_sp > XB_SPIN_CAP) { atomicAdd(&(bar)[XB_TMO], 1u); break; } } } } while (0)
struct XcdBarrier { unsigned* bar; unsigned x; volatile LAS unsigned* st; };
__device__ __forceinline__ XcdBarrier xcd_barrier_post(unsigned* bar, volatile LAS unsigned* st) {
    XcdBarrier b; b.bar = bar; b.x = xb_xcc_id(); b.st = st;
    if (threadIdx.x == 0) (void)xb_add(&bar[XB_XCNT(b.x)], 1u);
    return b;
}
__device__ __forceinline__ void xcd_barrier_complete(unsigned* bar, unsigned x, unsigned& nloc, unsigned& nx) {
    const unsigned G = gridDim.x * gridDim.y * gridDim.z;
    unsigned sum, cnt, mine, sp = 0u;
    for (;;) {
        sum = 0u; cnt = 0u; mine = 0u;
#pragma unroll
        for (unsigned j = 0; j < 16; ++j) { const unsigned c = xb_ld(&bar[XB_XCNT(j)]); sum += c; cnt += (c > 0u) ? 1u : 0u; mine = (j == x) ? c : mine; }
        if (sum == G) break;
        __builtin_amdgcn_s_sleep(1);
        if ((++sp & 255u) == 0u) { if (xb_ld(&bar[XB_TMO])) break; if (sp > XB_SPIN_CAP) { atomicAdd(&bar[XB_TMO], 1u); break; } }
    }
    nloc = mine > 0u ? mine : 1u; nx = cnt > 0u ? cnt : 1u;
}
__device__ __forceinline__ void xcd_barrier(unsigned* bar, volatile LAS unsigned* st, const int tid) {
    asm volatile("s_waitcnt vmcnt(0)" ::: "memory");
    __syncthreads();
    if (tid == 0) {
        const unsigned x = xb_xcc_id();
        __builtin_amdgcn_s_waitcnt(0);
        unsigned nloc = st[0], nx = st[1];
        if (nloc == 0u) { xcd_barrier_complete(bar, x, nloc, nx); st[0] = nloc; st[1] = nx; }
        const unsigned old = xb_add(&bar[XB_XSUB(x)], 1u);
        const unsigned gen = old / nloc;
        if (old + 1u == (gen + 1u) * nloc) {
            __builtin_amdgcn_fence(__ATOMIC_RELEASE, "agent");
            asm volatile("s_waitcnt vmcnt(0)" ::: "memory");
            const unsigned og = xb_add(&bar[XB_TOP], 1u);
            const unsigned tg = og / nx;
            if (og + 1u == (tg + 1u) * nx) xb_add(&bar[XB_TOPGEN], 1u);
            else XB_SPIN(xb_ld(&bar[XB_TOPGEN]) == tg, bar);
            __builtin_amdgcn_fence(__ATOMIC_ACQUIRE, "agent");
            xb_add(&bar[XB_XGEN(x)], 1u);
            asm volatile("s_waitcnt vmcnt(0)" ::: "memory");
        } else {
            XB_SPIN(xb_ld(&bar[XB_XGEN(x)]) == gen, bar);
            __builtin_amdgcn_fence(__ATOMIC_ACQUIRE, "agent");
            asm volatile("s_waitcnt vmcnt(0)" ::: "memory");
        }
    }
    __syncthreads();
}

struct EpiQKVG {
    static constexpr bool PERM = true, AFTER_DRAIN = false;
    bf16_t* qkv; bf16_t* gates; const float* bgate; const float* cosT; const float* sinT; float* kmean;
    __device__ __forceinline__ void operator()(const f32x4 (&acc)[2][2][4][2], const Unit& u, int wr, int wc, int fr, int fq) const {
        const int row0 = u.pm * 256 + wr * 64 + fr;
#pragma unroll
        for (int bj = 0; bj < 2; ++bj) {
            const int col = u.pn * 256 + bj * 128 + wc * 32 + 8 * fq;
            if (u.pn < 18) {
                const int which = col / MIXW, rem = col - which * MIXW, head = rem >> 6, dc = rem & 63;
                const bool rope = (which < 2) && (head < 18);
                const bool ksum_on = (which == 1) && (head >= 12) && (head < 18);
                const float sc = (which == 0) ? 0.125f * 1.4426950408889634f : 1.0f;
                if (rope) {
                    f32x4 c4[8], s4[8];
#pragma unroll
                    for (int i = 0; i < 8; ++i) { const int pos = (row0 + (i >> 2) * 128 + (i & 3) * 16) & (SEQ - 1);
                        c4[i] = *(const f32x4*)(cosT + (unsigned)(pos * 32 + (dc >> 1))); s4[i] = *(const f32x4*)(sinT + (unsigned)(pos * 32 + (dc >> 1))); }
                    float ks[8];
#pragma unroll
                    for (int j = 0; j < 8; ++j) ks[j] = 0.f;
#pragma unroll
                    for (int i = 0; i < 8; ++i) {
                        const int ai = i >> 2, m = i & 3, row = row0 + ai * 128 + m * 16;
                        const f32x4 v0 = acc[ai][bj][m][0], v1 = acc[ai][bj][m][1];
                        float r[8];
                        r[0] = v0[0] * c4[i][0] - v0[1] * s4[i][0]; r[1] = v0[0] * s4[i][0] + v0[1] * c4[i][0];
                        r[2] = v0[2] * c4[i][1] - v0[3] * s4[i][1]; r[3] = v0[2] * s4[i][1] + v0[3] * c4[i][1];
                        r[4] = v1[0] * c4[i][2] - v1[1] * s4[i][2]; r[5] = v1[0] * s4[i][2] + v1[1] * c4[i][2];
                        r[6] = v1[2] * c4[i][3] - v1[3] * s4[i][3]; r[7] = v1[2] * s4[i][3] + v1[3] * c4[i][3];
                        if (ksum_on) {
#pragma unroll
                            for (int j = 0; j < 8; ++j) ks[j] += r[j];
                        }
                        u32x4 w; w.x = pk2(r[0] * sc, r[1] * sc); w.y = pk2(r[2] * sc, r[3] * sc); w.z = pk2(r[4] * sc, r[5] * sc); w.w = pk2(r[6] * sc, r[7] * sc);
                        __builtin_nontemporal_store(w, (u32x4*)(qkv + (unsigned)(row * LDQ + col)));
                    }
                    if (ksum_on) {
#pragma unroll
                        for (int j = 0; j < 8; ++j) {
                            float v = ks[j];
                            v += swz_xor<1>(v); v += swz_xor<2>(v); v += swz_xor<4>(v); v += swz_xor<8>(v);
                            ks[j] = v;
                        }
                        if (fr == 0) {
                            float* dst = kmean + (size_t)(((u.pm >> 3) * 6 + (head - 12)) * 8 + (u.pm & 7)) * 64 + dc;
#pragma unroll
                            for (int j = 0; j < 8; ++j) atomicAdd(dst + j, ks[j]);
                        }
                    }
                } else {
#pragma unroll
                    for (int i = 0; i < 8; ++i) {
                        const int ai = i >> 2, m = i & 3, row = row0 + ai * 128 + m * 16;
                        const f32x4 v0 = acc[ai][bj][m][0] * sc, v1 = acc[ai][bj][m][1] * sc;
                        u32x4 w; w.x = pk2(v0[0], v0[1]); w.y = pk2(v0[2], v0[3]); w.z = pk2(v1[0], v1[1]); w.w = pk2(v1[2], v1[3]);
                        __builtin_nontemporal_store(w, (u32x4*)(qkv + (unsigned)(row * LDQ + col)));
                    }
                }
            } else {
                const int gcol = col - LDQ;
                const f32x4 b0 = *(const f32x4*)(bgate + gcol), b1 = *(const f32x4*)(bgate + gcol + 4);
#pragma unroll
                for (int ai = 0; ai < 2; ++ai)
#pragma unroll
                    for (int m = 0; m < 4; ++m) {
                        const int row = row0 + ai * 128 + m * 16;
                        const f32x4 v0 = acc[ai][bj][m][0] + b0, v1 = acc[ai][bj][m][1] + b1;
                        u32x4 w; w.x = pk2(sigmoidf_(v0[0]), sigmoidf_(v0[1])); w.y = pk2(sigmoidf_(v0[2]), sigmoidf_(v0[3]));
                        w.z = pk2(sigmoidf_(v1[0]), sigmoidf_(v1[1])); w.w = pk2(sigmoidf_(v1[2]), sigmoidf_(v1[3]));
                        __builtin_nontemporal_store(w, (u32x4*)(gates + (unsigned)(row * NG + gcol)));
                    }
            }
            asm volatile("" ::: "memory");
        }
    }
};
struct EpiBranch {
    static constexpr bool PERM = true, AFTER_DRAIN = false;
    const bf16_t* gates; bf16_t* merged;
    __device__ __forceinline__ void operator()(const f32x4 (&acc)[2][2][4][2], const Unit& us, int wr, int wc, int fr, int fq) const {
        const int br = us.pm >> 6; Unit u; u.pm = us.pm & 63; u.pn = us.pn & 3;
        const int row0 = u.pm * 256 + wr * 64 + fr;
#pragma unroll
        for (int ai = 0; ai < 2; ++ai)
#pragma unroll
            for (int m = 0; m < 4; ++m) {
                const int row = row0 + ai * 128 + m * 16;
#pragma unroll
                for (int bj = 0; bj < 2; ++bj) {
                    const int col = u.pn * 256 + bj * 128 + wc * 32 + 8 * fq;
                    const u32x4 g = *(const u32x4*)(gates + (unsigned)(row * NG + br * DM + col));
                    const f32x4 v0 = acc[ai][bj][m][0], v1 = acc[ai][bj][m][1];
                    float o[8];
                    o[0] = bflo(g.x) * v0[0]; o[1] = bfhi(g.x) * v0[1]; o[2] = bflo(g.y) * v0[2]; o[3] = bfhi(g.y) * v0[3];
                    o[4] = bflo(g.z) * v1[0]; o[5] = bfhi(g.z) * v1[1]; o[6] = bflo(g.w) * v1[2]; o[7] = bfhi(g.w) * v1[3];
                    bf16_t* dst = merged + (unsigned)(row * DM + col);
                    if (br > 0) {
                        const u32x4 p = *(const u32x4*)dst;
                        o[0] += bflo(p.x); o[1] += bfhi(p.x); o[2] += bflo(p.y); o[3] += bfhi(p.y);
                        o[4] += bflo(p.z); o[5] += bfhi(p.z); o[6] += bflo(p.w); o[7] += bfhi(p.w);
                    }
                    u32x4 w; w.x = pk2(o[0], o[1]); w.y = pk2(o[2], o[3]); w.z = pk2(o[4], o[5]); w.w = pk2(o[6], o[7]);
                    *(u32x4*)dst = w;
                }
                asm volatile("" ::: "memory");
            }
    }
};
struct RowStats {
    unsigned* xbuf;
    unsigned* cnt;
    __device__ __forceinline__ void run(const f32x4 (&v)[2][2][4][2], const Unit& u, int wr, int wc, int fr, int fq, LAS unsigned char* lds, int wid, int lane) const {
        LAS float* P = (LAS float*)lds;
        LAS float* S = (LAS float*)(lds + 4096);
#pragma unroll
        for (int ai = 0; ai < 2; ++ai)
#pragma unroll
            for (int m = 0; m < 4; ++m) {
                float q = 0.f;
#pragma unroll
                for (int bj = 0; bj < 2; ++bj)
#pragma unroll
                    for (int n = 0; n < 2; ++n) { const f32x4 x = v[ai][bj][m][n]; q += (x[0] * x[0] + x[1] * x[1]) + (x[2] * x[2] + x[3] * x[3]); }
                q += swz_xor<16>(q); q = xor32_sum(q);
                if (fq == 0) P[(ai * 128 + wr * 64 + m * 16 + fr) * 4 + wc] = q;
            }
        asm volatile("s_waitcnt lgkmcnt(0)" ::: "memory"); __builtin_amdgcn_s_barrier(); asm volatile("" ::: "memory");
        const int row = wid * 32 + (lane & 31);
        if (lane < 32) {
            const float t = (P[row * 4 + 0] + P[row * 4 + 1]) + (P[row * 4 + 2] + P[row * 4 + 3]);
            __hip_atomic_store(xbuf + ((size_t)(u.pm * 256 + row) * 4 + u.pn), __float_as_uint(t), __ATOMIC_RELAXED, __HIP_MEMORY_SCOPE_AGENT);
        }
        asm volatile("s_waitcnt vmcnt(0)" ::: "memory");
        if (lane == 0) __hip_atomic_fetch_add(cnt + 64 * u.pm, 1u, __ATOMIC_RELAXED, __HIP_MEMORY_SCOPE_AGENT);
        if (wid == 0) {
            unsigned sp = 0;
            for (;;) {
                if ((unsigned)__builtin_amdgcn_readfirstlane((int)__hip_atomic_load(cnt + 64 * u.pm, __ATOMIC_RELAXED, __HIP_MEMORY_SCOPE_AGENT)) >= 32u) break;
                if (++sp > (1u << 22)) break;
                __builtin_amdgcn_s_sleep(2);
            }
            __builtin_amdgcn_fence(__ATOMIC_ACQUIRE, "agent");
        }
        asm volatile("s_waitcnt vmcnt(0) lgkmcnt(0)" ::: "memory"); __builtin_amdgcn_s_barrier(); asm volatile("" ::: "memory");
        if (lane < 32) {
            const unsigned* slot = xbuf + (size_t)(u.pm * 256 + row) * 4;
            float t = 0.f;
#pragma unroll
            for (int k = 0; k < 4; ++k) t += __uint_as_float(__hip_atomic_load(slot + k, __ATOMIC_RELAXED, __HIP_MEMORY_SCOPE_AGENT));
            S[row] = 1.0f / sqrtf(t * (1.0f / DM) + NORM_EPS);
        }
        asm volatile("s_waitcnt lgkmcnt(0)" ::: "memory"); __builtin_amdgcn_s_barrier(); asm volatile("" ::: "memory");
    }
};
struct EpiResidNorm {
    static constexpr bool PERM = true, AFTER_DRAIN = true;
    const float* xin32; const bf16_t* xin16; bf16_t* xout16; float* yout; const float* gate; bf16_t* hout; const float* ng; const float* sc; const float* sh; RowStats st; int mode;
    __device__ __forceinline__ void operator()(const f32x4 (&)[2][2][4][2], const Unit&, int, int, int, int) const {}
    __device__ __forceinline__ void fused(f32x4 (&acc)[2][2][4][2], const Unit& u, int wr, int wc, int fr, int fq, LAS unsigned char* lds, int wid, int lane) const {
        const int row0 = u.pm * 256 + wr * 64 + fr;
        const unsigned boff = (unsigned)((u.pm >> 3) * 6 * DM);
#pragma unroll
        for (int bj = 0; bj < 2; ++bj) {
            const int col = u.pn * 256 + bj * 128 + wc * 32 + 8 * fq;
            const f32x4 g0 = *(const f32x4*)(gate + boff + col), g1 = *(const f32x4*)(gate + boff + col + 4);
            if (xin32) {
#pragma unroll
                for (int ai = 0; ai < 2; ++ai)
#pragma unroll
                    for (int m = 0; m < 4; ++m) {
                        const float* xp = xin32 + (unsigned)((row0 + ai * 128 + m * 16) * DM + col);
                        const f32x4 x0 = *(const f32x4*)xp, x1 = *(const f32x4*)(xp + 4);
                        acc[ai][bj][m][0] = x0 + g0 * acc[ai][bj][m][0]; acc[ai][bj][m][1] = x1 + g1 * acc[ai][bj][m][1];
                        asm volatile("" : "+v"(acc[ai][bj][m][0]), "+v"(acc[ai][bj][m][1]));
                        if (m & 1) asm volatile("" ::: "memory");
                    }
            } else {
#pragma unroll
                for (int ai = 0; ai < 2; ++ai)
#pragma unroll
                    for (int m = 0; m < 4; ++m) {
                        const u32x4 xw = *(const u32x4*)(xin16 + (unsigned)((row0 + ai * 128 + m * 16) * DM + col));
                        const f32x4 x0 = (f32x4){bflo(xw.x), bfhi(xw.x), bflo(xw.y), bfhi(xw.y)}, x1 = (f32x4){bflo(xw.z), bfhi(xw.z), bflo(xw.w), bfhi(xw.w)};
                        acc[ai][bj][m][0] = x0 + g0 * acc[ai][bj][m][0]; acc[ai][bj][m][1] = x1 + g1 * acc[ai][bj][m][1];
                        asm volatile("" : "+v"(acc[ai][bj][m][0]), "+v"(acc[ai][bj][m][1]));
                    }
            }
            asm volatile("" ::: "memory");
        }
        st.run(acc, u, wr, wc, fr, fq, lds, wid, lane);
        const LAS float* S = (const LAS float*)(lds + 4096);
#pragma unroll
        for (int bj = 0; bj < 2; ++bj) {
            const int col = u.pn * 256 + bj * 128 + wc * 32 + 8 * fq;
            f32x4 gv0 = *(const f32x4*)(ng + col), gv1 = *(const f32x4*)(ng + col + 4), sh0 = (f32x4){0.f, 0.f, 0.f, 0.f}, sh1 = sh0;
            if (mode == 0) { gv0 = gv0 * (*(const f32x4*)(sc + boff + col) + 1.0f); gv1 = gv1 * (*(const f32x4*)(sc + boff + col + 4) + 1.0f);
                             sh0 = *(const f32x4*)(sh + boff + col); sh1 = *(const f32x4*)(sh + boff + col + 4); }
#pragma unroll
            for (int ai = 0; ai < 2; ++ai)
#pragma unroll
                for (int m = 0; m < 4; ++m) {
                    const int r = ai * 128 + wr * 64 + m * 16 + fr;
                    const unsigned off = (unsigned)((u.pm * 256 + r) * DM + col);
                    const f32x4 x0 = acc[ai][bj][m][0], x1 = acc[ai][bj][m][1];
                    const float rs = S[r];
                    const f32x4 y0 = x0 * rs * gv0 + sh0, y1 = x1 * rs * gv1 + sh1;
                    if (mode == 0) {
                        u32x4 xw; xw.x = pk2(x0[0], x0[1]); xw.y = pk2(x0[2], x0[3]); xw.z = pk2(x1[0], x1[1]); xw.w = pk2(x1[2], x1[3]);
                        *(u32x4*)(xout16 + off) = xw;
                        u32x4 hw; hw.x = pk2(y0[0], y0[1]); hw.y = pk2(y0[2], y0[3]); hw.z = pk2(y1[0], y1[1]); hw.w = pk2(y1[2], y1[3]);
                        *(u32x4*)(hout + off) = hw;
                    } else {
                        *(f32x4*)(yout + off) = y0; *(f32x4*)(yout + off + 4) = y1;
                    }
                    if (m & 1) asm volatile("" ::: "memory");
                }
        }
    }
};
struct EpiSwiGLU {
    static constexpr bool PERM = true, AFTER_DRAIN = false;
    bf16_t* act;
    __device__ __forceinline__ void operator()(const f32x4 (&acc)[2][2][4][2], const Unit& u, int wr, int wc, int fr, int fq) const {
        const int row0 = u.pm * 256 + wr * 64 + fr;
        const int col = u.pn * 128 + wc * 32 + 8 * fq;
#pragma unroll
        for (int ai = 0; ai < 2; ++ai)
#pragma unroll
            for (int m = 0; m < 4; ++m) {
                const int row = row0 + ai * 128 + m * 16;
                float o[8];
#pragma unroll
                for (int n = 0; n < 2; ++n)
#pragma unroll
                    for (int j = 0; j < 4; ++j) { const float gt = acc[ai][0][m][n][j], up = acc[ai][1][m][n][j]; o[4 * n + j] = gt * sigmoidf_(gt) * up; }
                u32x4 w; w.x = pk2(o[0], o[1]); w.y = pk2(o[2], o[3]); w.z = pk2(o[4], o[5]); w.w = pk2(o[6], o[7]);
                __builtin_nontemporal_store(w, (u32x4*)(act + (unsigned)(row * DFF + col)));
                asm volatile("" ::: "memory");
            }
    }
};

struct BranchOrder {
    pg8::StaticOrder base;
    __device__ __forceinline__ bool next(int i, Unit& u) const { Unit t; if (!base.next(i / 3, t)) return false; const int br = i % 3; u.pm = br * 64 + t.pm; u.pn = br * 4 + t.pn; return true; }
    __device__ __forceinline__ void a_ready(const Unit&) const {}
    __device__ __forceinline__ void done(const Unit&) const {}
};
struct LimitOrder {
    pg8::StaticOrder base; int lim;
    __device__ __forceinline__ bool next(int i, Unit& u) const { return i < lim && base.next(i, u); }
    __device__ __forceinline__ void a_ready(const Unit&) const {}
    __device__ __forceinline__ void done(const Unit&) const {}
};
struct OneUnit {
    Unit u0;
    __device__ __forceinline__ bool next(int i, Unit& u) const { if (i != 0) return false; u = u0; return true; }
    __device__ __forceinline__ void a_ready(const Unit&) const {}
    __device__ __forceinline__ void done(const Unit&) const {}
};
__device__ __forceinline__ int rowmap(int kind, int n) {
    if (kind == 1) { const int which = n / MIXW, rem = n - which * MIXW, head = rem >> 6, d = rem & 63;
        const int dd = (which < 2 && head < 18) ? (2 * (d & 31) + (d >> 5)) : d; return which * MIXW + head * 64 + dd; }
    if (kind == 2) { const int up = n >= DFF, j = up ? n - DFF : n; return (j >> 7) * 256 + up * 128 + (j & 127); }
    return n;
}
__device__ __forceinline__ void transpose_item(const float* W, int K, int N, bf16_t* WT, int ldk, int row_off, int kind, LAS float* scr, int item, int lane) {
    const int nblk = N / 32, kb = item / nblk, nb = item % nblk, k0 = 64 * kb, n0 = 32 * nb;
#pragma unroll 8
    for (int i = 0; i < 32; ++i) { const int kk = 2 * i + (lane >> 5); scr[kk * 33 + (lane & 31)] = W[(size_t)(k0 + kk) * N + n0 + (lane & 31)]; }
    asm volatile("s_waitcnt lgkmcnt(0)" ::: "memory");
    const int c = lane & 7;
#pragma unroll
    for (int j = 0; j < 4; ++j) { const int n = (lane >> 3) + 8 * j; const LAS float* s = scr + (8 * c) * 33 + n;
        u32x4 o; o.x = pk2(s[0 * 33], s[1 * 33]); o.y = pk2(s[2 * 33], s[3 * 33]); o.z = pk2(s[4 * 33], s[5 * 33]); o.w = pk2(s[6 * 33], s[7 * 33]);
        *(u32x4*)(WT + (size_t)(row_off + rowmap(kind, n0 + n)) * ldk + k0 + 8 * c) = o; }
    asm volatile("s_waitcnt lgkmcnt(0)" ::: "memory");
}

#define MFMA32(a, b, c) __builtin_amdgcn_mfma_f32_32x32x16_bf16((a), (b), (c), 0, 0, 0)
constexpr int VROW = 144;
constexpr int VTILE = 32 * VROW;
__device__ __forceinline__ int crow(int r, int h) { return (r & 3) + 8 * (r >> 2) + 4 * h; }
__device__ __forceinline__ s16x4 vtr(const LAS unsigned char* p) { return __builtin_bit_cast(s16x4, __builtin_amdgcn_ds_read_tr16_b64_v4i16((LAS v4i16_t*)p)); }

struct WaveCtx { int lane, q, h; LAS unsigned char* vl; int troff; };

__device__ __forceinline__ void load_q(bf16x8 (&qf)[4], const bf16_t* qrow, int h) {
#pragma unroll
    for (int ks = 0; ks < 4; ++ks) qf[ks] = *(const bf16x8*)(qrow + 16 * ks + 8 * h);
}
template <bool CLAMP>
__device__ __forceinline__ void load_k(bf16x8 (&kf)[4], const bf16_t* kbase, int k0, int kst, const WaveCtx& c) {
    int kp = k0 + kst * c.q; if (CLAMP) kp = kp < 0 ? 0 : (kp > SEQ - 1 ? SEQ - 1 : kp);
    const bf16_t* kr = kbase + (size_t)kp * LDQ + 8 * c.h;
#pragma unroll
    for (int ks = 0; ks < 4; ++ks) kf[ks] = *(const bf16x8*)(kr + 16 * ks);
}
template <bool CLAMP>
__device__ __forceinline__ void load_v(u32x4 (&vr)[4], const bf16_t* vbase, int k0, int kst, const WaveCtx& c) {
#pragma unroll
    for (int i = 0; i < 4; ++i) { const int p = c.lane + 64 * i, n = p >> 3; int kp = k0 + kst * n; if (CLAMP) kp = kp < 0 ? 0 : (kp > SEQ - 1 ? SEQ - 1 : kp);
        vr[i] = *(const u32x4*)(vbase + (size_t)kp * LDQ + (p & 7) * 8); }
}
__device__ __forceinline__ void store_v(const u32x4 (&vr)[4], const WaveCtx& c) {
#pragma unroll
    for (int i = 0; i < 4; ++i) { const int p = c.lane + 64 * i, n = p >> 3; *(LAS u32x4*)(c.vl + n * VROW + (p & 7) * 16) = vr[i]; }
}
struct VF { bf16x8 v[2][2]; };
__device__ __forceinline__ void read_vf_at(VF& f, const LAS unsigned char* vb, const WaveCtx& c) {
#pragma unroll
    for (int dt = 0; dt < 2; ++dt)
#pragma unroll
        for (int s2 = 0; s2 < 2; ++s2) {
            const LAS unsigned char* a = vb + c.troff + (16 * s2) * VROW + dt * 64;
            const s16x4 lo = vtr(a), hi = vtr(a + 8 * VROW);
            f.v[dt][s2] = (bf16x8){lo[0], lo[1], lo[2], lo[3], hi[0], hi[1], hi[2], hi[3]};
        }
}
__device__ __forceinline__ void read_vf(VF& f, const WaveCtx& c) {
#pragma unroll
    for (int dt = 0; dt < 2; ++dt)
#pragma unroll
        for (int s2 = 0; s2 < 2; ++s2) {
            const LAS unsigned char* a = c.vl + c.troff + (16 * s2) * VROW + dt * 64;
            const s16x4 lo = vtr(a), hi = vtr(a + 8 * VROW);
            f.v[dt][s2] = (bf16x8){lo[0], lo[1], lo[2], lo[3], hi[0], hi[1], hi[2], hi[3]};
        }
}
__device__ __forceinline__ void pv(f32x16 (&o)[2], const f32x16& p, const VF& f) {
    bf16x8 pb[2];
#pragma unroll
    for (int s2 = 0; s2 < 2; ++s2) {
        u32x4 w; w.x = pk2(p[8 * s2 + 0], p[8 * s2 + 1]); w.y = pk2(p[8 * s2 + 2], p[8 * s2 + 3]); w.z = pk2(p[8 * s2 + 4], p[8 * s2 + 5]); w.w = pk2(p[8 * s2 + 6], p[8 * s2 + 7]);
        pb[s2] = __builtin_bit_cast(bf16x8, w);
    }
#pragma unroll
    for (int s2 = 0; s2 < 2; ++s2)
#pragma unroll
        for (int dt = 0; dt < 2; ++dt) o[dt] = MFMA32(f.v[dt][s2], pb[s2], o[dt]);
}
__device__ __forceinline__ f32x16 qk(const bf16x8 (&kf)[4], const bf16x8 (&qf)[4]) {
    f32x16 s0, s1;
#pragma unroll
    for (int r = 0; r < 16; ++r) { s0[r] = 0.f; s1[r] = 0.f; }
    s0 = MFMA32(kf[0], qf[0], s0); s1 = MFMA32(kf[2], qf[2], s1);
    s0 = MFMA32(kf[1], qf[1], s0); s1 = MFMA32(kf[3], qf[3], s1);
    return s0 + s1;
}
__device__ __forceinline__ f32x16 qk_ref(const bf16x8 (&kf)[4], const bf16x8 (&qf)[4], const f32x16& negm) {
    f32x16 s = MFMA32(kf[0], qf[0], negm);
    s = MFMA32(kf[1], qf[1], s); s = MFMA32(kf[2], qf[2], s); s = MFMA32(kf[3], qf[3], s);
    return s;
}
struct SoftState { f32x16 o[2]; f32x16 negm; float m, l; };
struct KV { bf16x8 kf[4]; u32x4 vr[4]; };
template <bool CLAMP>
__device__ __forceinline__ void issue_kv(KV& t, const bf16_t* kbase, const bf16_t* vbase, int k0, int kst, const WaveCtx& c) { load_k<CLAMP>(t.kf, kbase, k0, kst, c); load_v<CLAMP>(t.vr, vbase, k0, kst, c); }
__device__ __forceinline__ void soft_init(SoftState& st) {
#pragma unroll
    for (int r = 0; r < 16; ++r) { st.o[0][r] = 0.f; st.o[1][r] = 0.f; }
    st.m = 0.f; st.l = 0.f;
#pragma unroll
    for (int r = 0; r < 16; ++r) st.negm[r] = 0.f;
}
template <int MODE>
__device__ __forceinline__ void soft_compute(SoftState& st, const bf16x8 (&qf)[4], const KV& t, int k0, int kst, int qp, int W, int dilm1, bool lane_ok, bool diag, const WaveCtx& c) {
    store_v(t.vr, c);
    VF vf; read_vf(vf, c);
    f32x16 s = qk_ref(t.kf, qf, st.negm);
    if (MODE == 0) {
        const int relb = qp - k0;
        const bool cls_ok = ((relb & dilm1) == 0);
#pragma unroll
        for (int r = 0; r < 16; ++r) {
            const unsigned rel = (unsigned)(relb - kst * crow(r, c.h));
            s[r] = (cls_ok && rel <= (unsigned)W) ? s[r] : -1e30f;
        }

    } else if (diag) {
#pragma unroll
        for (int r = 0; r < 16; ++r) { const int kp = k0 + crow(r, c.h); s[r] = (kp <= qp) ? s[r] : -1e30f; }
    } else if (__ballot(!lane_ok) != 0ull) {
#pragma unroll
        for (int r = 0; r < 16; ++r) s[r] = lane_ok ? s[r] : -1e30f;
    }
    float mx = fmaxf(fmaxf(s[0], s[1]), fmaxf(s[2], s[3]));
#pragma unroll
    for (int r = 4; r < 16; r += 4) mx = fmaxf(mx, fmaxf(fmaxf(s[r], s[r + 1]), fmaxf(s[r + 2], s[r + 3])));
    mx = xor32_max(mx);
    if (__ballot(mx > 8.0f) != 0ull) {
        const float d = fmaxf(mx, 0.f), scl = __builtin_amdgcn_exp2f(-d);
        st.l *= scl; st.m += d;
        const float nm = -st.m;
#pragma unroll
        for (int r = 0; r < 16; ++r) { st.o[0][r] *= scl; st.o[1][r] *= scl; s[r] -= d; st.negm[r] = nm; }
    }
    float ps = 0.f;
#pragma unroll
    for (int r = 0; r < 16; ++r) { const float p = __builtin_amdgcn_exp2f(s[r]); s[r] = p; ps += p; }
    st.l += xor32_sum(ps);
    pv(st.o, s, vf);
}
__device__ __forceinline__ void store_o(const f32x16 (&o)[2], float inv, bf16_t* orow, const WaveCtx& c) {
#pragma unroll
    for (int dt = 0; dt < 2; ++dt)
#pragma unroll
        for (int r4 = 0; r4 < 4; ++r4) {
            u32x2 w; w.x = pk2(o[dt][4 * r4] * inv, o[dt][4 * r4 + 1] * inv); w.y = pk2(o[dt][4 * r4 + 2] * inv, o[dt][4 * r4 + 3] * inv);
            *(u32x2*)(orow + 32 * dt + 8 * r4 + 4 * c.h) = w;
        }
}

__device__ __forceinline__ void unit_A(const bf16_t* qkv, bf16_t* outA, int b, int slot, int blk, int w, const WaveCtx& c) {
    const int cls0 = (w & 3) + 8 * (w >> 2), cls = cls0 + 4 * (c.q >> 4), qp = 256 * blk + cls + 16 * (c.q & 15);
    const bf16_t* rowb = qkv + (size_t)b * SEQ * LDQ;
    SoftState st; soft_init(st);
    for (int g = 0; g < 3; ++g) {
        const int dil = 1 << (2 * g), W = 128 * dil, head = 4 * g + slot;
        bf16x8 qf[4]; load_q(qf, rowb + (size_t)qp * LDQ + head * 64, c.h);
        const bf16_t* kbase = rowb + MIXW + head * 64; const bf16_t* vbase = rowb + 2 * MIXW + head * 64;
        int ks0, ks1 = 0, n0, n1 = 0;
        if (g == 0) { ks0 = 256 * blk + cls0 - 128; if (ks0 < 0) ks0 = 0; const int kend = 256 * blk + cls0 + 4 + 240; n0 = ((kend - ks0) + 1 + 31) >> 5; }
        else if (g == 1) {
            const int lo = 256 * blk - W;
            ks0 = (lo < 0) ? (cls0 & 3) : (cls0 + lo);
            n0 = ((256 * blk + cls0 + 4 + 240 - ks0) / dil + 1 + 31) >> 5;
        } else {
            const int lo = 256 * blk - W;
            const int c0 = cls0, c1 = cls0 + 4;
            ks0 = (lo < 0) ? (c0 & (dil - 1)) : (c0 + lo); ks1 = (lo < 0) ? (c1 & (dil - 1)) : (c1 + lo);
            n0 = ((256 * blk + c0 + 240 - ks0) / dil + 1 + 31) >> 5; n1 = ((256 * blk + c1 + 240 - ks1) / dil + 1 + 31) >> 5;
        }
        const int ntot = n0 + n1, step = 32 * dil;
        KV ta, tb;
        issue_kv<true>(ta, kbase, vbase, ks0, dil, c);
#define A_K0(i) (((i) < n0) ? (ks0 + step * (i)) : (ks1 + step * ((i) - n0)))
        for (int i = 0; i < ntot; i += 2) {
            if (i + 1 < ntot) issue_kv<true>(tb, kbase, vbase, A_K0(i + 1), dil, c);
            soft_compute<0>(st, qf, ta, A_K0(i), dil, qp, W, dil - 1, true, false, c);
            if (i + 1 >= ntot) break;
            if (i + 2 < ntot) issue_kv<true>(ta, kbase, vbase, A_K0(i + 2), dil, c);
            soft_compute<0>(st, qf, tb, A_K0(i + 1), dil, qp, W, dil - 1, true, false, c);
        }
#undef A_K0
    }
    store_o(st.o, __builtin_amdgcn_rcpf(st.l), outA + (size_t)(b * SEQ + qp) * 384 + slot * 64, c);
}
constexpr int A2_T = 40960, A2_STRIDE = 68, A2_M = A2_T + 256 * A2_STRIDE * 4, A2_L = A2_M + 1024;
__device__ __forceinline__ void unit_A2(const bf16_t* qkv, bf16_t* outA, int b, int slot, int blk, int w, LAS unsigned char* lds, const WaveCtx& c) {
    const bf16_t* rowb = qkv + (size_t)b * SEQ * LDQ;
    SoftState st; soft_init(st);
    {
        const int qp1 = 256 * blk + 32 * w + c.q, head = slot;
        bf16x8 qf[4]; load_q(qf, rowb + (size_t)qp1 * LDQ + head * 64, c.h);
        const bf16_t* kbase = rowb + MIXW + head * 64; const bf16_t* vbase = rowb + 2 * MIXW + head * 64;
        int ks0 = 256 * blk + 32 * w - 128; if (ks0 < 0) ks0 = 0;
        const int ntot = ((256 * blk + 32 * w + 31 - ks0) + 1 + 31) >> 5;
        KV ta, tb;
        issue_kv<true>(ta, kbase, vbase, ks0, 1, c);
        for (int i = 0; i < ntot; i += 2) {
            if (i + 1 < ntot) issue_kv<true>(tb, kbase, vbase, ks0 + 32 * (i + 1), 1, c);
            soft_compute<0>(st, qf, ta, ks0 + 32 * i, 1, qp1, 128, 0, true, false, c);
            if (i + 1 >= ntot) break;
            if (i + 2 < ntot) issue_kv<true>(ta, kbase, vbase, ks0 + 32 * (i + 2), 1, c);
            soft_compute<0>(st, qf, tb, ks0 + 32 * (i + 1), 1, qp1, 128, 0, true, false, c);
        }
    }
    LAS float* T = (LAS float*)(lds + A2_T); LAS float* Mt = (LAS float*)(lds + A2_M); LAS float* Lt = (LAS float*)(lds + A2_L);
    {
        const int qi = 32 * w + c.q;
#pragma unroll
        for (int dt = 0; dt < 2; ++dt)
#pragma unroll
            for (int r4 = 0; r4 < 4; ++r4)
                *(LAS f32x4*)(T + qi * A2_STRIDE + 32 * dt + 8 * r4 + 4 * c.h) = (f32x4){st.o[dt][4 * r4], st.o[dt][4 * r4 + 1], st.o[dt][4 * r4 + 2], st.o[dt][4 * r4 + 3]};
        if (c.h == 0) { Mt[qi] = st.m; Lt[qi] = st.l; }
    }
    __syncthreads();
    const int cls0 = (w & 3) + 8 * (w >> 2), cls = cls0 + 4 * (c.q >> 4), qi2 = cls + 16 * (c.q & 15), qp = 256 * blk + qi2;
    {
#pragma unroll
        for (int dt = 0; dt < 2; ++dt)
#pragma unroll
            for (int r4 = 0; r4 < 4; ++r4) {
                const f32x4 v = *(const LAS f32x4*)(T + qi2 * A2_STRIDE + 32 * dt + 8 * r4 + 4 * c.h);
                st.o[dt][4 * r4] = v[0]; st.o[dt][4 * r4 + 1] = v[1]; st.o[dt][4 * r4 + 2] = v[2]; st.o[dt][4 * r4 + 3] = v[3];
            }
        st.m = Mt[qi2]; st.l = Lt[qi2];
        const float nm = -st.m;
#pragma unroll
        for (int r = 0; r < 16; ++r) st.negm[r] = nm;
    }
    for (int g = 1; g < 3; ++g) {
        const int dil = 1 << (2 * g), W = 128 * dil, head = 4 * g + slot;
        bf16x8 qf[4]; load_q(qf, rowb + (size_t)qp * LDQ + head * 64, c.h);
        const bf16_t* kbase = rowb + MIXW + head * 64; const bf16_t* vbase = rowb + 2 * MIXW + head * 64;
        int ks0, ks1 = 0, n0, n1 = 0;
        const int lo = 256 * blk - W;
        if (g == 1) { ks0 = (lo < 0) ? (cls0 & 3) : (cls0 + lo); n0 = ((256 * blk + cls0 + 4 + 240 - ks0) / dil + 1 + 31) >> 5; }
        else { const int c0 = cls0, c1 = cls0 + 4;
            ks0 = (lo < 0) ? (c0 & (dil - 1)) : (c0 + lo); ks1 = (lo < 0) ? (c1 & (dil - 1)) : (c1 + lo);
            n0 = ((256 * blk + c0 + 240 - ks0) / dil + 1 + 31) >> 5; n1 = ((256 * blk + c1 + 240 - ks1) / dil + 1 + 31) >> 5; }
        const int ntot = n0 + n1, step = 32 * dil;
        KV ta, tb;
        issue_kv<true>(ta, kbase, vbase, ks0, dil, c);
#define A_K0(i) (((i) < n0) ? (ks0 + step * (i)) : (ks1 + step * ((i) - n0)))
        for (int i = 0; i < ntot; i += 2) {
            if (i + 1 < ntot) issue_kv<true>(tb, kbase, vbase, A_K0(i + 1), dil, c);
            soft_compute<0>(st, qf, ta, A_K0(i), dil, qp, W, dil - 1, true, false, c);
            if (i + 1 >= ntot) break;
            if (i + 2 < ntot) issue_kv<true>(ta, kbase, vbase, A_K0(i + 2), dil, c);
            soft_compute<0>(st, qf, tb, A_K0(i + 1), dil, qp, W, dil - 1, true, false, c);
        }
#undef A_K0
    }
    store_o(st.o, __builtin_amdgcn_rcpf(st.l), outA + (size_t)(b * SEQ + qp) * 384 + slot * 64, c);
}
__device__ __forceinline__ void soft_compute_lds(SoftState& st, const bf16x8 (&qf)[4], const LAS unsigned char* kc, const LAS unsigned char* vc, int k0, int qp, bool lane_ok, bool diag, const WaveCtx& c) {
    bf16x8 kf[4];
#pragma unroll
    for (int ks = 0; ks < 4; ++ks) kf[ks] = *(const LAS bf16x8*)(kc + c.q * VROW + ks * 32 + c.h * 16);
    f32x16 s = qk_ref(kf, qf, st.negm);
    if (diag) {
#pragma unroll
        for (int r = 0; r < 16; ++r) { const int kp = k0 + crow(r, c.h); s[r] = (kp <= qp) ? s[r] : -1e30f; }
    } else if (__ballot(!lane_ok) != 0ull) {
#pragma unroll
        for (int r = 0; r < 16; ++r) s[r] = lane_ok ? s[r] : -1e30f;
    }
    float mx = fmaxf(fmaxf(s[0], s[1]), fmaxf(s[2], s[3]));
#pragma unroll
    for (int r = 4; r < 16; r += 4) mx = fmaxf(mx, fmaxf(fmaxf(s[r], s[r + 1]), fmaxf(s[r + 2], s[r + 3])));
    mx = xor32_max(mx);
    if (__ballot(mx > 8.0f) != 0ull) {
        const float d = fmaxf(mx, 0.f), scl = __builtin_amdgcn_exp2f(-d);
        st.l *= scl; st.m += d;
        const float nm = -st.m;
#pragma unroll
        for (int r = 0; r < 16; ++r) { st.o[0][r] *= scl; st.o[1][r] *= scl; s[r] -= d; st.negm[r] = nm; }
    }
    float ps = 0.f;
#pragma unroll
    for (int r = 0; r < 16; ++r) { const float p = __builtin_amdgcn_exp2f(s[r]); s[r] = p; ps += p; }
    st.l += xor32_sum(ps);
    VF vf; read_vf_at(vf, vc, c);
    pv(st.o, s, vf);
}
constexpr int BST = 128 * VROW;
__device__ __forceinline__ void wg_unit_B(const bf16_t* qkv, const float* kmean, bf16_t* outB, int b, int hb, int qb, LAS unsigned char* lds, int wid, const WaveCtx& c, int tid) {
    const int own = qb, qt = 8 * qb + wid, qp = 32 * qt + c.q, head = 12 + hb;
    const bf16_t* rowb = qkv + (size_t)b * SEQ * LDQ;
    bf16x8 qf[4]; load_q(qf, rowb + (size_t)qp * LDQ + head * 64, c.h);
    const bf16_t* kbase = rowb + MIXW + head * 64; const bf16_t* vbase = rowb + 2 * MIXW + head * 64;
    float gate[7];
#pragma unroll
    for (int n = 0; n < 7; ++n) {
        gate[n] = -INFINITY;
        if (n < own) {
            const float* km = kmean + (size_t)((b * 6 + hb) * 8 + n) * 64 + 8 * c.h;
            float a = 0.f;
#pragma unroll
            for (int ks = 0; ks < 4; ++ks) {
                const f32x4 k0 = *(const f32x4*)(km + 16 * ks), k1 = *(const f32x4*)(km + 16 * ks + 4);
#pragma unroll
                for (int j = 0; j < 4; ++j) { a += bf2f((unsigned short)qf[ks][j]) * k0[j]; a += bf2f((unsigned short)qf[ks][4 + j]) * k1[j]; }
            }
            a = xor32_sum(a);
            gate[n] = a;
        }
    }
    unsigned sel = 0;
#pragma unroll
    for (int n = 0; n < 7; ++n) {
        if (n < own) {
            int rank = 0;
#pragma unroll
            for (int m2 = 0; m2 < 7; ++m2) if (m2 < own && m2 != n) rank += (gate[m2] > gate[n] || (gate[m2] == gate[n] && m2 < n)) ? 1 : 0;
            if (rank < 3) sel |= 1u << n;
        }
    }
    unsigned vis = 0;
#pragma unroll
    for (int n = 0; n < 7; ++n) if (n < own && __ballot((sel >> n) & 1u) != 0ull) vis |= 1u << n;
    LAS unsigned* wv = (LAS unsigned*)(lds + 131072 + 128);
    if (tid == 0) *wv = 0u;
    __syncthreads();
    if (c.lane == 0 && vis) __hip_atomic_fetch_or((unsigned*)wv, vis, __ATOMIC_RELAXED, __HIP_MEMORY_SCOPE_WORKGROUP);
    __syncthreads();
    const unsigned visw = *wv;
    const int nsteps = 2 * (__popc(visw) + 1);
    const int srow = tid >> 3, spc = tid & 7;
    u32x4 kr[2], vr[2];
#define BW_LOAD(blk_, half_) do { const int r0_ = 256 * (blk_) + 128 * (half_) + srow; \
        kr[0] = *(const u32x4*)(kbase + (size_t)r0_ * LDQ + spc * 8); kr[1] = *(const u32x4*)(kbase + (size_t)(r0_ + 64) * LDQ + spc * 8); \
        vr[0] = *(const u32x4*)(vbase + (size_t)r0_ * LDQ + spc * 8); vr[1] = *(const u32x4*)(vbase + (size_t)(r0_ + 64) * LDQ + spc * 8); } while (0)
#define BW_WRITE(buf_) do { LAS unsigned char* kb_ = lds + (buf_) * 2 * BST; LAS unsigned char* vb_ = kb_ + BST; \
        *(LAS u32x4*)(kb_ + srow * VROW + spc * 16) = kr[0]; *(LAS u32x4*)(kb_ + (srow + 64) * VROW + spc * 16) = kr[1]; \
        *(LAS u32x4*)(vb_ + srow * VROW + spc * 16) = vr[0]; *(LAS u32x4*)(vb_ + (srow + 64) * VROW + spc * 16) = vr[1]; } while (0)
    SoftState st; soft_init(st);
    unsigned rem = visw; int blk = rem ? (int)__builtin_ctz(rem) : own, half = 0;
    BW_LOAD(blk, 0); BW_WRITE(0);
    __syncthreads();
    for (int sidx = 0; sidx < nsteps; ++sidx) {
        int nblk = blk, nhalf = half ^ 1; unsigned nrem = rem;
        if (half == 1) { nrem = rem & (rem - 1u); nblk = nrem ? (int)__builtin_ctz(nrem) : own; }
        const bool has_next = (sidx + 1 < nsteps);
        if (has_next) BW_LOAD(nblk, nhalf);
        const LAS unsigned char* kst = lds + (sidx & 1) * 2 * BST; const LAS unsigned char* vst = kst + BST;
        if (blk == own) {
#pragma unroll 1
            for (int ch = 0; ch < 4; ++ch) { const int ci = 4 * half + ch;
                if (ci <= wid) soft_compute_lds(st, qf, kst + ch * 32 * VROW, vst + ch * 32 * VROW, 256 * blk + 32 * ci, qp, true, ci == wid, c); }
        } else if ((vis >> blk) & 1u) {
            const bool mine = ((sel >> blk) & 1u) != 0u;
#pragma unroll 1
            for (int ch = 0; ch < 4; ++ch) soft_compute_lds(st, qf, kst + ch * 32 * VROW, vst + ch * 32 * VROW, 256 * blk + 128 * half + 32 * ch, qp, mine, false, c);
        }
        if (has_next) BW_WRITE((sidx + 1) & 1);
        __syncthreads();
        blk = nblk; half = nhalf; rem = nrem;
    }
#undef BW_LOAD
#undef BW_WRITE
    store_o(st.o, __builtin_amdgcn_rcpf(st.l), outB + (size_t)(b * SEQ + qp) * 384 + hb * 64, c);
}
__device__ __forceinline__ void unit_C(const bf16_t* qkv, bf16_t* outC, int b, int hc, int qt, const WaveCtx& c) {
    const int qp = 32 * qt + c.q, head = 18 + hc;
    const bf16_t* rowb = qkv + (size_t)b * SEQ * LDQ;
    bf16x8 qf[4]; load_q(qf, rowb + (size_t)qp * LDQ + head * 64, c.h);
    const bf16_t* kbase = rowb + MIXW + head * 64; const bf16_t* vbase = rowb + 2 * MIXW + head * 64;
    f32x16 o[2];
#pragma unroll
    for (int r = 0; r < 16; ++r) { o[0][r] = 0.f; o[1][r] = 0.f; }
    float carry = 0.f;
    KV ta, tb;
    issue_kv<false>(ta, kbase, vbase, 32 * qt, 1, c);
    bool done = false;
#define C_STEP(T, ch) do { \
        const int k0 = 32 * (ch); \
        store_v(T.vr, c); VF vf; read_vf(vf, c); \
        f32x16 z = qk(T.kf, qf); \
        float lk[16], gs[4]; \
        const bool diag = ((ch) == qt); \
        _Pragma("unroll") for (int r = 0; r < 16; ++r) { \
            const bool ok = diag ? ((k0 + crow(r, c.h)) < qp) : true; \
            const float zz = z[r], sp = fmaxf(zz, 0.f) + __builtin_amdgcn_logf(1.0f + __builtin_amdgcn_exp2f(-fabsf(zz)));   \
            lk[r] = ok ? -sp : 0.f; \
            z[r] = ok ? (zz - sp) : -1e30f; } \
        _Pragma("unroll") for (int g4 = 0; g4 < 4; ++g4) gs[g4] = (lk[4 * g4] + lk[4 * g4 + 1]) + (lk[4 * g4 + 2] + lk[4 * g4 + 3]); \
        float os[4]; \
        _Pragma("unroll") for (int g4 = 0; g4 < 4; ++g4) os[g4] = xor32_get(gs[g4], c.h); \
        float T_ = 0.f; \
        _Pragma("unroll") for (int g4 = 3; g4 >= 0; --g4) { \
            const float base = carry + T_ + (c.h == 0 ? os[g4] : 0.f); \
            const float a3 = base, a2 = a3 + lk[4 * g4 + 3], a1 = a2 + lk[4 * g4 + 2], a0 = a1 + lk[4 * g4 + 1]; \
            z[4 * g4 + 3] = __builtin_amdgcn_exp2f(z[4 * g4 + 3] + a3); z[4 * g4 + 2] = __builtin_amdgcn_exp2f(z[4 * g4 + 2] + a2); \
            z[4 * g4 + 1] = __builtin_amdgcn_exp2f(z[4 * g4 + 1] + a1); z[4 * g4 + 0] = __builtin_amdgcn_exp2f(z[4 * g4 + 0] + a0); \
            T_ += gs[g4] + os[g4]; } \
        carry += T_; \
        pv(o, z, vf); \
        done = (__ballot(carry > -150.5f) == 0ull);   } while (0)
    for (int ch = qt; ch >= 0; ch -= 2) {
        if (ch > 0) issue_kv<false>(tb, kbase, vbase, 32 * (ch - 1), 1, c);
        C_STEP(ta, ch);
        if (done || ch == 0) break;
        if (ch > 1) issue_kv<false>(ta, kbase, vbase, 32 * (ch - 2), 1, c);
        C_STEP(tb, ch - 1);
        if (done) break;
    }
#undef C_STEP
    store_o(o, 1.0f, outC + (size_t)(b * SEQ + qp) * 384 + hc * 64, c);
}

__device__ __forceinline__ void attn_phase(const Params& p, unsigned char* ws, int layer, LAS unsigned char* lds, const int tid, int rep) {
    const int wid = __builtin_amdgcn_readfirstlane(tid >> 6);
    const bf16_t* qkv = (const bf16_t*)(ws + WS_QKV);
    const float* kmean = (const float*)(ws + WS_KMEAN);
    bf16_t* outA = (bf16_t*)(ws + WS_ATTA); bf16_t* outB = (bf16_t*)(ws + WS_ATTB); bf16_t* outC = (bf16_t*)(ws + WS_ATTC);
    if (wid >= 4) __builtin_amdgcn_s_setprio(1);
    const bool a_static = (gridDim.x == 256);
    if (a_static) {
        int t2 = tid; asm volatile("" : "+v"(t2));
        const int lane = t2 & 63;
        WaveCtx c; c.lane = lane; c.q = lane & 31; c.h = lane >> 5; c.vl = lds + wid * VTILE;
        { const int i = lane & 15, qq = i >> 2, pp = i & 3, blk = (lane >> 4) & 1; c.troff = (4 * c.h + qq) * VROW + (16 * blk + 4 * pp) * 2; }
        const int g8 = (int)blockIdx.x, jb = g8 >> 3;
        unit_A2(qkv, outA, g8 & 7, jb >> 3, jb & 7, wid, lds, c);
        __syncthreads();
    }
    for (int rb = 0; rb < REP_B; ++rb) {
        unsigned* ctrB = (unsigned*)(ws + WS_CTR) + 4096 + (layer * 2 + rb) * 64;
        LAS unsigned* qw = (LAS unsigned*)(lds + 131072 + 192);
        for (;;) {
            int t2 = tid; asm volatile("" : "+v"(t2));
            const int lane = t2 & 63;
            WaveCtx c; c.lane = lane; c.q = lane & 31; c.h = lane >> 5; c.vl = lds;
            { const int i = lane & 15, qq = i >> 2, pp = i & 3, blk = (lane >> 4) & 1; c.troff = (4 * c.h + qq) * VROW + (16 * blk + 4 * pp) * 2; }
            __syncthreads();
            if (t2 == 0) *qw = atomicAdd(ctrB, 1u);
            __syncthreads();
            const unsigned u = (unsigned)__builtin_amdgcn_readfirstlane((int)*qw);
            const unsigned ngu = (gridDim.x == 256) ? 128u : 0u;
            if (u >= 384u + ngu) break;
            if (u >= 192u && u < 192u + ngu) {
                pg8::StaticOrder so; so.init(M, NQKVG, 256, (int)(u - 192u));
                OneUnit S1; so.next(7, S1.u0);
                pg8::Gemm g{(const bf16_t*)(ws + WS_H), (const bf16_t*)(ws + WS_W + W_QKVG), M, NQKVG, DM};
                EpiQKVG E{(bf16_t*)(ws + WS_QKV), (bf16_t*)(ws + WS_GATES), p.b_gate + (size_t)layer * NG, (const float*)(ws + WS_COS), (const float*)(ws + WS_SIN), (float*)(ws + WS_KMEAN)};
                pg8::gemm_phase<EpiQKVG, OneUnit, false, GSP2>(lds, g, S1, E, t2);
                if (wid >= 4) __builtin_amdgcn_s_setprio(1);
                continue;
            }
            const unsigned ub = (u < 192u) ? u : u - ngu;
            const int qb = 7 - (int)(ub / 48u), r2 = (int)(ub % 48u);
            wg_unit_B(qkv, kmean, outB, r2 / 6, r2 % 6, qb, lds, wid, c, t2);
        }
        __syncthreads();
    }
    const int qid = blockIdx.x & 7;
    for (int rac = 0; rac < REP_AC; ++rac) {
    unsigned* ctr = (unsigned*)(ws + WS_CTR) + ((layer * 8 + qid) * 2 + rac) * 64;
    for (;;) {
        int t2 = tid; asm volatile("" : "+v"(t2));
        const int lane = t2 & 63;
        WaveCtx c; c.lane = lane; c.q = lane & 31; c.h = lane >> 5; c.vl = lds + wid * VTILE;
        { const int i = lane & 15, qq = i >> 2, pp = i & 3, blk = (lane >> 4) & 1; c.troff = (4 * c.h + qq) * VROW + (16 * blk + 4 * pp) * 2; }
        unsigned u = 0;
        if (lane == 0) u = atomicAdd(ctr, 1u);
        u = (unsigned)__builtin_amdgcn_readfirstlane((int)u);
        if (a_static) u += 256u;
        if (u >= 640u) break;
        const int wgu = (int)(u >> 3) * 8 + qid, sub = (int)(u & 7);
        if (wgu < 256) { unit_A(qkv, outA, wgu >> 5, (wgu & 31) >> 3, wgu & 7, sub, c); }
        else { const int w2 = wgu - 256, qb = 7 - w2 / 48, r2 = w2 % 48; unit_C(qkv, outC, r2 / 6, r2 % 6, qb * 8 + sub, c); }
    }
    }
    __builtin_amdgcn_s_setprio(0);
}

__device__ __forceinline__ void phase0(const Params& p, LAS unsigned char* lds, const int tid) {
    const int lane = tid & 63, wid = tid >> 6;
    LAS float* cact = (LAS float*)lds;
    if (blockIdx.x == 0) { for (int i = tid; i < 4096 + DEPTH * 2 * 64; i += NTHR) ((unsigned*)(p.ws + WS_CTR))[i] = 0u; }
    {
        float* cosT = (float*)(p.ws + WS_COS); float* sinT = (float*)(p.ws + WS_SIN);
        for (int i = blockIdx.x * NTHR + tid; i < SEQ * 32; i += gridDim.x * NTHR) {
            const int pos = i >> 5, j = i & 31;
            const float inv = exp2f(-(float)j * 0.41524101186092029f);
            const float ang = (float)pos * inv;
            double a = (double)ang; const double twopi = 6.283185307179586476925;
            a -= twopi * rint(a / twopi);
            const double a2 = a * a;
            double cs = 1.0, term = 1.0, sn = a, ts = a;
#pragma unroll 1
            for (int k = 1; k <= 14; ++k) { term *= -a2 / (double)((2 * k - 1) * (2 * k)); cs += term; ts *= -a2 / (double)((2 * k) * (2 * k + 1)); sn += ts; }
            cosT[i] = (float)cs; sinT[i] = (float)sn;
        }
    }
    for (int i = blockIdx.x * NTHR + tid; i < 8 * 64 * 64; i += 256 * NTHR) { if (blockIdx.x < 256) ((unsigned*)(p.ws + WS_CNT))[i] = 0u; }
    for (int i = blockIdx.x * NTHR + tid; i < M * 16; i += 256 * NTHR) { if (blockIdx.x < 256) *(u32x4*)((bf16_t*)(p.ws + WS_ATTA) + (size_t)(i >> 4) * 384 + 256 + (i & 15) * 8) = (u32x4){0u, 0u, 0u, 0u}; }
    for (int i = tid; i < NB * DM; i += NTHR) { const float v = p.c[i]; cact[i] = v / (1.0f + __expf(-v)); }
    __syncthreads();
    float* mod = (float*)(p.ws + WS_MOD);
    LAS float* red2 = (LAS float*)(lds + 32768);
    const int hw = tid >> 5, cl = tid & 31;
    for (int unit = blockIdx.x; unit < DEPTH * 192; unit += gridDim.x) {
        const int l = unit / 192, n0 = (unit % 192) * 32;
        const float* W = p.w_ada + (size_t)l * DM * 6 * DM + (size_t)(hw * 64) * 6 * DM + n0 + cl;
        float a[8];
#pragma unroll
        for (int b = 0; b < 8; ++b) a[b] = 0.f;
#pragma unroll 1
        for (int kb = 0; kb < 64; kb += 16) {
            float w[16];
#pragma unroll
            for (int j = 0; j < 16; ++j) w[j] = W[(size_t)(kb + j) * 6 * DM];
#pragma unroll
            for (int j = 0; j < 16; ++j)
#pragma unroll
                for (int b = 0; b < 8; ++b) a[b] += cact[b * DM + hw * 64 + kb + j] * w[j];
        }
#pragma unroll
        for (int b = 0; b < 8; ++b) red2[(hw * 8 + b) * 32 + cl] = a[b];
        __syncthreads();
        if (tid < 256) {
            const int b = tid >> 5; float sum = 0.f;
#pragma unroll
            for (int h2 = 0; h2 < 16; ++h2) sum += red2[(h2 * 8 + b) * 32 + cl];
            mod[((size_t)l * NB + b) * 6 * DM + n0 + cl] = sum + p.b_ada[(size_t)l * 6 * DM + n0 + cl];
        }
        __syncthreads();
    }
}
__device__ __forceinline__ void norm_rows(const float* x, const float* g, const float* modl  , int sh_off, int sc_off, bf16_t* h, int gw, int ngw, int lane) {
    f32x4 gv[4];
#pragma unroll
    for (int j = 0; j < 4; ++j) gv[j] = *((const f32x4*)g + lane + 64 * j);
    for (int row = gw; row < M; row += ngw) {
        const f32x4* xr = (const f32x4*)(x + (size_t)row * DM) + lane;
        f32x4 v[4]; float ss = 0.f;
#pragma unroll
        for (int j = 0; j < 4; ++j) { v[j] = xr[64 * j]; ss += (v[j].x * v[j].x + v[j].y * v[j].y) + (v[j].z * v[j].z + v[j].w * v[j].w); }
        const float rstd = 1.0f / sqrtf(wave_sum(ss) * (1.0f / DM) + NORM_EPS);
        const float* mb = modl + (size_t)(row >> 11) * 6 * DM;
        unsigned long long* o8 = (unsigned long long*)(h + (size_t)row * DM) + lane;
#pragma unroll
        for (int j = 0; j < 4; ++j) {
            const f32x4 sc = *((const f32x4*)(mb + sc_off) + lane + 64 * j), sh = *((const f32x4*)(mb + sh_off) + lane + 64 * j);
            const f32x4 y = v[j] * rstd * gv[j] * (sc + 1.0f) + sh;
            o8[64 * j] = (unsigned long long)pk2(y.x, y.y) | ((unsigned long long)pk2(y.z, y.w) << 32);
        }
    }
}
__device__ __forceinline__ void final_norm(float* x, const float* g, int gw, int ngw, int lane) {
    f32x4 gv[4];
#pragma unroll
    for (int j = 0; j < 4; ++j) gv[j] = *((const f32x4*)g + lane + 64 * j);
    for (int row = gw; row < M; row += ngw) {
        f32x4* xr = (f32x4*)(x + (size_t)row * DM) + lane;
        f32x4 v[4]; float ss = 0.f;
#pragma unroll
        for (int j = 0; j < 4; ++j) { v[j] = xr[64 * j]; ss += (v[j].x * v[j].x + v[j].y * v[j].y) + (v[j].z * v[j].z + v[j].w * v[j].w); }
        const float rstd = 1.0f / sqrtf(wave_sum(ss) * (1.0f / DM) + NORM_EPS);
#pragma unroll
        for (int j = 0; j < 4; ++j) xr[64 * j] = v[j] * rstd * gv[j];
    }
}
__device__ __forceinline__ void convert_weights(const Params& p, unsigned char* ws, int l, LAS unsigned char* lds, int gw, int ngw, int wid, int lane) {
    LAS float* scr = (LAS float*)(lds + wid * 16384);
    unsigned char* wb = ws + WS_W;
    constexpr int I_IN = 16 * 144, I_G = 16 * 96, I_A = 4 * 32, I_B = 6 * 32, I_O = 16 * 32, I_GU = 16 * 176, I_D = 44 * 32;
    constexpr int NIT = I_IN + I_G + I_A + 2 * I_B + I_O + I_GU + I_D;
    for (int it = gw; it < NIT; it += ngw) {
        int r = it;
        if (r < I_IN) { transpose_item(p.w_in + (size_t)l * DM * LDQ, DM, LDQ, (bf16_t*)(wb + W_QKVG), DM, 0, 1, scr, r, lane); continue; } r -= I_IN;
        if (r < I_G) { transpose_item(p.w_gate + (size_t)l * DM * NG, DM, NG, (bf16_t*)(wb + W_QKVG), DM, LDQ, 0, scr, r, lane); continue; } r -= I_G;
        if (r < I_A) { transpose_item(p.w_br_a + (size_t)l * 256 * DM, 256, DM, (bf16_t*)(wb + W_A), 384, 0, 0, scr, r, lane); continue; } r -= I_A;
        if (r < I_B) { transpose_item(p.w_br_b + (size_t)l * 384 * DM, 384, DM, (bf16_t*)(wb + W_B), 384, 0, 0, scr, r, lane); continue; } r -= I_B;
        if (r < I_B) { transpose_item(p.w_br_c + (size_t)l * 384 * DM, 384, DM, (bf16_t*)(wb + W_C), 384, 0, 0, scr, r, lane); continue; } r -= I_B;
        if (r < I_O) { transpose_item(p.w_out + (size_t)l * DM * DM, DM, DM, (bf16_t*)(wb + W_O), DM, 0, 0, scr, r, lane); continue; } r -= I_O;
        if (r < I_GU) { transpose_item(p.w_gu + (size_t)l * DM * NGU, DM, NGU, (bf16_t*)(wb + W_GU), DM, 0, 2, scr, r, lane); continue; } r -= I_GU;
        transpose_item(p.w_down + (size_t)l * DFF * DM, DFF, DM, (bf16_t*)(wb + W_D), DFF, 0, 0, scr, r, lane);
    }
    { unsigned z = 0u; asm volatile("" : "+v"(z));
      for (int r = gw; r < DM; r += ngw) { if (lane < 16) *(u32x4*)((bf16_t*)(wb + W_A) + (size_t)r * 384 + 256 + lane * 8) = (u32x4){z, z, z, z}; } }
}

constexpr int PPL = 7;
constexpr int N_PHASES = 1 + PPL * DEPTH;
__global__ void __launch_bounds__(NTHR, 2) fwd_kernel(Params p) {
    extern __shared__ __attribute__((aligned(16))) unsigned char lds_raw[];
    LAS unsigned char* lds = (LAS unsigned char*)lds_raw;
    const int G = gridDim.x, ngw = G * NWAVES;
    volatile LAS unsigned* bst = (volatile LAS unsigned*)(lds + 131072 + 64);
    if (threadIdx.x < 2) bst[threadIdx.x] = 0u;
    __syncthreads();
    (void)xcd_barrier_post((unsigned*)(p.ws + WS_BAR), bst);
    if (p.ph_lo == 0) {
        int tid = threadIdx.x; asm volatile("" : "+v"(tid));
        for (int rep = 0; rep < REP_P0; ++rep) { phase0(p, lds, tid); __syncthreads(); }
        if (p.ph_hi > 1) xcd_barrier((unsigned*)(p.ws + WS_BAR), (volatile LAS unsigned*)(lds + 131072 + 64), tid);
        if (p.ph_hi < 0) cg::this_grid().sync();
    }
    const int ph_a = p.ph_lo < 1 ? 1 : p.ph_lo, ph_b = p.ph_hi;
    const int wid_s = __builtin_amdgcn_readfirstlane((int)(threadIdx.x >> 6));
    for (int ph = ph_a; ph < ph_b; ++ph) {
        unsigned ones = ~0u; asm volatile("" : "+s"(ones));
        int tid = wid_s * 64 + (int)__builtin_amdgcn_mbcnt_hi(ones, __builtin_amdgcn_mbcnt_lo(ones, 0u)); asm volatile("" : "+v"(tid));
        unsigned char* ws = p.ws; asm volatile("" : "+s"(ws));
        float* mod = (float*)(ws + WS_MOD);
        bf16_t* H = (bf16_t*)(ws + WS_H); bf16_t* QKV = (bf16_t*)(ws + WS_QKV); bf16_t* GATES = (bf16_t*)(ws + WS_GATES);
        bf16_t* MERGED = (bf16_t*)(ws + WS_MERGED); bf16_t* ACT = (bf16_t*)(ws + WS_QKV);
        unsigned char* wb = ws + WS_W;
        {
            const int l = (ph - 1) / PPL, k = (ph - 1) % PPL;
            const float* modl = mod + (size_t)l * NB * 6 * DM;
            const float* xin = (l == 0) ? p.x : p.out;
            switch (k) {
#if PHEN(0)
            case 0: {
                float* km = (float*)(ws + WS_KMEAN);
                if (blockIdx.x == 0) { for (int i = tid; i < NB * 6 * 8 * 64; i += NTHR) km[i] = 0.f; }
                const int lane = tid & 63, wid = __builtin_amdgcn_readfirstlane(tid >> 6), gw = blockIdx.x * NWAVES + wid;
                convert_weights(p, ws, l, lds, gw, ngw, wid, lane);
                if (l == 0) norm_rows(p.x, p.norm1_g, modl, 0, DM, H, gw, ngw, lane);
            } break;
#endif
#if PHEN(1)
            case 1: {
                pg8::Gemm g{H, (const bf16_t*)(wb + W_QKVG), M, NQKVG, DM}; LimitOrder S; S.base.init(M, NQKVG, G, (int)blockIdx.x); S.lim = (G == 256) ? 7 : 1000;
                EpiQKVG E{QKV, GATES, p.b_gate + (size_t)l * NG, (const float*)(ws + WS_COS), (const float*)(ws + WS_SIN), (float*)(ws + WS_KMEAN)};
                pg8::gemm_phase<EpiQKVG, LimitOrder, GALIGN, GSP2>(lds, g, S, E, tid);
            } break;
#endif
#if PHEN(2)
            case 2: for (int rep = 0; rep < REP_ATT; ++rep) { attn_phase(p, ws, l, lds, tid, rep); __syncthreads(); } break;
#endif
#if PHEN(3)
            case 3: {
                pg8::Gemm g{(const bf16_t*)(ws + WS_ATTA), (const bf16_t*)(wb + W_A), 3 * M, 3 * DM, 384};
                BranchOrder S; S.base.init(M, DM, G, (int)blockIdx.x);
                EpiBranch E{GATES, MERGED};
                pg8::gemm_phase<EpiBranch, BranchOrder, GALIGN, GSP2>(lds, g, S, E, tid);
            } break;
#endif
#if PHEN(4)
            case 4: {
                pg8::Gemm g{MERGED, (const bf16_t*)(wb + W_O), M, DM, DM}; pg8::StaticOrder S; S.init(M, DM, G, (int)blockIdx.x);
                RowStats rs{(unsigned*)(ws + WS_XBUF), (unsigned*)(ws + WS_CNT) + (size_t)(2 * l) * 64 * 64};
                EpiResidNorm E{l == 0 ? p.x : nullptr, (const bf16_t*)(ws + WS_X16), (bf16_t*)(ws + WS_GATES), nullptr, modl + 2 * DM, H, p.norm2_g + (size_t)l * DM, modl + 4 * DM, modl + 3 * DM, rs, 0};
                pg8::gemm_phase<EpiResidNorm, pg8::StaticOrder, false, GSP2>(lds, g, S, E, tid);
            } break;
#endif
#if PHEN(6)
            case 5: {
                pg8::Gemm g{H, (const bf16_t*)(wb + W_GU), M, NGU, DM}; pg8::StaticOrder S; S.init(M, NGU, G, (int)blockIdx.x);
                EpiSwiGLU E{ACT};
                pg8::gemm_phase<EpiSwiGLU, pg8::StaticOrder, GALIGN, GSP2>(lds, g, S, E, tid);
            } break;
#endif
#if PHEN(7)
            case 6: {
                pg8::Gemm g{ACT, (const bf16_t*)(wb + W_D), M, DM, DFF}; pg8::StaticOrder S; S.init(M, DM, G, (int)blockIdx.x);
                RowStats rs{(unsigned*)(ws + WS_XBUF), (unsigned*)(ws + WS_CNT) + (size_t)(2 * l + 1) * 64 * 64};
                const bool fin = (l == DEPTH - 1);
                const float* modn = mod + (size_t)(fin ? l : l + 1) * NB * 6 * DM;
                EpiResidNorm E{nullptr, (const bf16_t*)(ws + WS_GATES), (bf16_t*)(ws + WS_X16), p.out, modl + 5 * DM, H, fin ? p.final_g : p.norm1_g + (size_t)(l + 1) * DM, modn + DM, modn, rs, fin ? 1 : 0};
                pg8::gemm_phase<EpiResidNorm, pg8::StaticOrder, false, GSP2>(lds, g, S, E, tid);
            } break;
#endif
            default: break;
            }
        }
        if (ph + 1 < p.ph_hi) { for (int rep = 0; rep < REP_SYNC; ++rep) xcd_barrier((unsigned*)(ws + WS_BAR), (volatile LAS unsigned*)(lds + 131072 + 64), tid); }
    }
}

extern "C" void kernel_launch(void* const* d_in, const int* in_sizes, int n_in, void* d_out, int out_size, void* d_ws, size_t ws_size, hipStream_t stream) {
    static int grid = 0;
    if (grid == 0) {
        if (n_in != 16 || out_size != M * DM || ws_size < WS_END) { fprintf(stderr, "kernel_launch: unexpected sizes n_in %d out %d ws %zu\n", n_in, out_size, ws_size); grid = -1; return; }
        int dev = 0, cus = 0, per_cu = 0;
        if (hipGetDevice(&dev) != hipSuccess || hipDeviceGetAttribute(&cus, hipDeviceAttributeMultiprocessorCount, dev) != hipSuccess) { grid = -1; return; }
        if (hipFuncSetAttribute((const void*)fwd_kernel, hipFuncAttributeMaxDynamicSharedMemorySize, LDS_BYTES) != hipSuccess) { fprintf(stderr, "kernel_launch: hipFuncSetAttribute failed\n"); grid = -1; return; }
        if (hipOccupancyMaxActiveBlocksPerMultiprocessor(&per_cu, (const void*)fwd_kernel, NTHR, LDS_BYTES) != hipSuccess || per_cu < 1) { fprintf(stderr, "kernel_launch: occupancy query says %d\n", per_cu); per_cu = 1; }
        (void)hipGetLastError();
        grid = cus * 1;
    }
    if (grid < 0) return;
    if (hipMemsetAsync((char*)d_ws + WS_BAR, 0, XCD_BAR_WORDS * 4, stream) != hipSuccess) { fprintf(stderr, "kernel_launch: memset failed\n"); return; }
    Params p{};
    p.x = (const float*)d_in[0]; p.c = (const float*)d_in[1]; p.w_ada = (const float*)d_in[2]; p.b_ada = (const float*)d_in[3]; p.norm1_g = (const float*)d_in[4];
    p.w_in = (const float*)d_in[5]; p.w_br_a = (const float*)d_in[6]; p.w_br_b = (const float*)d_in[7]; p.w_br_c = (const float*)d_in[8]; p.w_gate = (const float*)d_in[9];
    p.b_gate = (const float*)d_in[10]; p.w_out = (const float*)d_in[11]; p.norm2_g = (const float*)d_in[12]; p.w_gu = (const float*)d_in[13]; p.w_down = (const float*)d_in[14];
    p.final_g = (const float*)d_in[15];
    p.out = (float*)d_out; p.ws = (unsigned char*)d_ws;
#if MK_MULTI_LAUNCH
    for (int ph = 0; ph < N_PHASES; ++ph) {
        p.ph_lo = ph; p.ph_hi = ph + 1;
        hipLaunchKernelGGL(fwd_kernel, dim3(grid), dim3(NTHR), LDS_BYTES, stream, p);
    }
#else
    p.ph_lo = 0; p.ph_hi = N_PHASES;
    void* args[] = {&p};
    hipError_t e = hipLaunchCooperativeKernel((const void*)fwd_kernel, dim3(grid), dim3(NTHR), args, LDS_BYTES, stream);
    if (e != hipSuccess) fprintf(stderr, "cooperative launch failed: %s (grid %d)\n", hipGetErrorString(e), grid);
#endif
}
```

```cpp
#include <hip/hip_runtime.h>
#include <hip/hip_cooperative_groups.h>
#include <cstdio>
#include <cstdint>
namespace cg = cooperative_groups;

#ifndef PHMASK
#define PHMASK 0xff
#endif
#define PHEN(k) ((PHMASK >> (k)) & 1)
#ifndef REPK
#define REPK -1
#endif
#ifndef REP_P0
#define REP_P0 1
#endif
#ifndef REP_B
#define REP_B 1
#endif
#ifndef REP_AC
#define REP_AC 1
#endif
#ifndef REP_ATT
#define REP_ATT 1
#endif
#ifndef REP_GU
#define REP_GU 1
#endif
#ifndef REP_SYNC
#define REP_SYNC 1
#endif
#ifndef REP_NORM
#define REP_NORM 1
#endif
#ifndef GALIGN
#define GALIGN true
#endif
#ifndef GSP2
#define GSP2 true
#endif
#ifndef MK_MULTI_LAUNCH
#define MK_MULTI_LAUNCH 0
#endif

namespace pg8 {
#define PG8_LAS __attribute__((address_space(3)))
typedef unsigned short bf16_t;
typedef short bf16x8 __attribute__((ext_vector_type(8)));
typedef float f32x4 __attribute__((ext_vector_type(4)));
typedef unsigned u32x4 __attribute__((ext_vector_type(4)));
constexpr int BM = 256, BK = 64, HALF = 128, HTB = HALF * BK * 2  , STAGE_BYTES = 8 * HTB, NXCD = 8, WGM = 8;

__host__ __device__ __forceinline__ int lds_byte(int r, int c) { const int st = (r >> 4) * 2 + (c >> 5), rr = r & 15, cc = c & 31, ob = rr * 64 + cc * 2; return st * 1024 + (ob ^ (((ob >> 9) & 1) << 5)); }
__host__ __device__ __forceinline__ void stage_rc(int b, int& R, int& C) { const int st = b / 1024, sb = b % 1024, swz = sb ^ (((sb >> 9) & 1) << 5); R = (st >> 1) * 16 + swz / 64; C = (st & 1) * 32 + (swz % 64) / 2; }
__host__ __device__ __forceinline__ int perm32(int rho) { const int n = rho >> 4, i = rho & 15; return 8 * (i >> 2) + 4 * n + (i & 3); }

struct Unit { int pm, pn; };
struct Gemm { const bf16_t* A; const bf16_t* Bt; int M, N, K; };

struct StaticOrder {
    int nM, nN, nwg, G, c;
    __host__ __device__ void init(int M, int N, int G_, int c_) { nM = M / BM; nN = N / BM; nwg = nM * nN; G = G_; c = c_; }
    __host__ __device__ bool next(int i, Unit& u) const {
        const long L = (long)i * G + c; if (L >= nwg) return false;
        int wgid = (int)L; { const int q = nwg / NXCD, r = nwg % NXCD, xcd = wgid % NXCD, off = wgid / NXCD; wgid = (xcd < r ? xcd * (q + 1) : r * (q + 1) + (xcd - r) * q) + off; }
        const int nig = WGM * nN, gid = wgid / nig, fm = gid * WGM, gsz = (nM - fm) < WGM ? (nM - fm) : WGM;
        u.pm = fm + ((wgid % nig) % gsz); u.pn = (wgid % nig) / gsz; return true;
    }
    __device__ __forceinline__ void a_ready(const Unit&) const {}
    __device__ __forceinline__ void done(const Unit&) const {}
};

__device__ __forceinline__ unsigned cvt_pk_bf16(float lo, float hi) { unsigned r; asm volatile("v_cvt_pk_bf16_f32 %0, %1, %2" : "=v"(r) : "v"(lo), "v"(hi)); return r; }

template <class Epi, class Sched, bool ALIGN_EPI = false, bool SP2 = false>
__device__ __forceinline__ void gemm_phase(PG8_LAS unsigned char* lds, const Gemm g, const Sched& S, const Epi& E, const int tid) {
    const int wid = __builtin_amdgcn_readfirstlane(tid >> 6), lane = tid & 63, wr = wid >> 2, wc = wid & 3, fr = lane & 15, fq = lane >> 4;
    const int K = g.K, nt = K / BK;
    unsigned voffA[2], voffB[2];
#pragma unroll
    for (int i = 0; i < 2; ++i) { int R, C; stage_rc(tid * 16 + i * 8192, R, C); const int Rb = Epi::PERM ? ((R & ~31) + perm32(R & 31)) : R;
        voffA[i] = (unsigned)(R * K + C) * 2u; voffB[i] = (unsigned)(Rb * K + C) * 2u; }
    const size_t kstep = (size_t)(BK * 2);
    const size_t hstep = (size_t)HALF * K * 2;
    const size_t tstep = 2 * hstep;
    const unsigned ldsw = (unsigned)wid * 1024u;
    const int aoff = lds_byte(wr * 64 + fr, fq * 8), boff = lds_byte(wc * 32 + fr, fq * 8);
#define PG8_SA(b, h) (((b) * 2 + (h)) * HTB)
#define PG8_SB(b, h) ((4 + (b) * 2 + (h)) * HTB)
#define PG8_STAGE(bufoff, gbase, voff) do { _Pragma("unroll") for (int _i = 0; _i < 2; ++_i) \
        __builtin_amdgcn_global_load_lds((const unsigned*)((const char*)(gbase) + (voff)[_i]), (PG8_LAS unsigned*)(lds + (bufoff) + ldsw + _i * 8192), 16, 0, 0); } while (0)
#define PG8_LDA(dst, b, h) do { _Pragma("unroll") for (int m = 0; m < 4; ++m) _Pragma("unroll") for (int k = 0; k < 2; ++k) dst[m][k] = *(const PG8_LAS bf16x8*)(lds + PG8_SA(b, h) + aoff + m * 2048 + k * 1024); } while (0)
#define PG8_LDB(dst, b, h) do { _Pragma("unroll") for (int n = 0; n < 2; ++n) _Pragma("unroll") for (int k = 0; k < 2; ++k) dst[n][k] = *(const PG8_LAS bf16x8*)(lds + PG8_SB(b, h) + boff + n * 2048 + k * 1024); } while (0)
#define PG8_MMA(ai, bj, At, Bt) do { __builtin_amdgcn_s_setprio(1); _Pragma("unroll") for (int m = 0; m < 4; ++m) _Pragma("unroll") for (int n = 0; n < 2; ++n) _Pragma("unroll") for (int k = 0; k < 2; ++k) \
        acc[ai][bj][m][n] = __builtin_amdgcn_mfma_f32_16x16x32_bf16(Bt[n][k], At[m][k], acc[ai][bj][m][n], 0, 0, 0); __builtin_amdgcn_s_setprio(0); } while (0)
#define PG8_WAIT_V(n) asm volatile("s_waitcnt vmcnt(" #n ")" ::: "memory")
#define PG8_WAIT_L(n) asm volatile("s_waitcnt lgkmcnt(" #n ")" ::: "memory")
#define PG8_BAR __builtin_amdgcn_s_barrier()
#define PG8_SCHED __builtin_amdgcn_sched_barrier(0)
    Unit cur, nxt; int ui = 0;
    if (!S.next(0, cur)) return;
    f32x4 acc[2][2][4][2];
#pragma unroll
    for (int a = 0; a < 2; ++a)
#pragma unroll
        for (int b = 0; b < 2; ++b)
#pragma unroll
            for (int m = 0; m < 4; ++m)
#pragma unroll
                for (int n = 0; n < 2; ++n) acc[a][b][m][n] = (f32x4){0.f, 0.f, 0.f, 0.f};
    bf16x8 At[4][2], B0[2][2], B1[2][2];
    const char* cA = (const char*)g.A + (size_t)cur.pm * tstep; const char* cB = (const char*)g.Bt + (size_t)cur.pn * tstep;
    S.a_ready(cur);
    if constexpr (SP2) {
        PG8_STAGE(PG8_SB(0, 0), cB, voffB); PG8_STAGE(PG8_SB(0, 1), cB + hstep, voffB); PG8_STAGE(PG8_SA(0, 0), cA, voffA); PG8_STAGE(PG8_SA(0, 1), cA + hstep, voffA);
        if (wr == 1) PG8_BAR;
        PG8_WAIT_V(2); PG8_BAR;
        PG8_STAGE(PG8_SB(1, 0), cB + kstep, voffB); PG8_STAGE(PG8_SA(1, 0), cA + kstep, voffA); PG8_STAGE(PG8_SB(1, 1), cB + hstep + kstep, voffB);
        PG8_WAIT_V(6); PG8_BAR;
    } else {
        PG8_STAGE(PG8_SB(0, 0), cB, voffB); PG8_STAGE(PG8_SA(0, 0), cA, voffA); PG8_STAGE(PG8_SB(0, 1), cB + hstep, voffB); PG8_STAGE(PG8_SA(0, 1), cA + hstep, voffA);
        if (wr == 1) PG8_BAR;
        PG8_WAIT_V(4); PG8_BAR;
        PG8_STAGE(PG8_SB(1, 0), cB + kstep, voffB); PG8_STAGE(PG8_SA(1, 0), cA + kstep, voffA); PG8_STAGE(PG8_SB(1, 1), cB + hstep + kstep, voffB);
        PG8_WAIT_V(6); PG8_BAR;
    }
    for (;;) {
        const bool has_next = S.next(ui + 1, nxt);
        const char* nA = has_next ? (const char*)g.A + (size_t)nxt.pm * tstep : cA; const char* nB = has_next ? (const char*)g.Bt + (size_t)nxt.pn * tstep : cB;
        for (int t = 0; t < nt; t += 2) {
            const bool last = (t == nt - 2);
            const char* a1 = cA + (size_t)(t + 1) * kstep;
            const char* a2 = last ? nA : cA + (size_t)(t + 2) * kstep; const char* b2 = last ? nB : cB + (size_t)(t + 2) * kstep;
            const char* a3 = a2 + kstep; const char* b3 = b2 + kstep;
            if (last && has_next) S.a_ready(nxt);
            if constexpr (SP2) {
            PG8_LDB(B0, 0, 0); PG8_LDB(B1, 0, 1); PG8_SCHED; PG8_LDA(At, 0, 0); PG8_STAGE(PG8_SA(1, 1), a1 + hstep, voffA);
            PG8_WAIT_V(8); PG8_WAIT_L(0); PG8_BAR; PG8_MMA(0, 0, At, B0); PG8_MMA(0, 1, At, B1); PG8_BAR; PG8_SCHED;
            PG8_LDA(At, 0, 1); PG8_STAGE(PG8_SB(0, 0), b2, voffB); PG8_STAGE(PG8_SB(0, 1), b2 + hstep, voffB); PG8_STAGE(PG8_SA(0, 0), a2, voffA);
            PG8_WAIT_V(8); PG8_WAIT_L(0); PG8_BAR; PG8_MMA(1, 0, At, B0); PG8_MMA(1, 1, At, B1); PG8_BAR; PG8_SCHED;
            PG8_LDB(B0, 1, 0); PG8_LDB(B1, 1, 1); PG8_SCHED; PG8_LDA(At, 1, 0); PG8_STAGE(PG8_SA(0, 1), a2 + hstep, voffA);
            PG8_WAIT_V(8); PG8_WAIT_L(0); PG8_BAR; PG8_MMA(0, 0, At, B0); PG8_MMA(0, 1, At, B1); PG8_BAR; PG8_SCHED;
            PG8_LDA(At, 1, 1); PG8_STAGE(PG8_SB(1, 0), b3, voffB); PG8_STAGE(PG8_SB(1, 1), b3 + hstep, voffB); PG8_STAGE(PG8_SA(1, 0), a3, voffA);
            PG8_WAIT_V(8); PG8_WAIT_L(0); PG8_BAR; PG8_MMA(1, 0, At, B0); PG8_MMA(1, 1, At, B1); PG8_BAR; PG8_SCHED;
            } else {
            PG8_LDB(B0, 0, 0); PG8_SCHED; PG8_LDA(At, 0, 0); PG8_STAGE(PG8_SA(1, 1), a1 + hstep, voffA);
            PG8_WAIT_L(8); PG8_BAR; PG8_WAIT_L(0); PG8_MMA(0, 0, At, B0); PG8_BAR; PG8_SCHED;
            PG8_LDB(B1, 0, 1); PG8_STAGE(PG8_SB(0, 0), b2, voffB);
            PG8_BAR; PG8_WAIT_L(0); PG8_MMA(0, 1, At, B1); PG8_BAR;
            PG8_LDA(At, 0, 1); PG8_STAGE(PG8_SA(0, 0), a2, voffA);
            PG8_BAR; PG8_WAIT_L(0); PG8_MMA(1, 0, At, B0); PG8_BAR; PG8_SCHED;
            PG8_STAGE(PG8_SB(0, 1), b2 + hstep, voffB);
            PG8_WAIT_V(6); PG8_BAR; PG8_MMA(1, 1, At, B1); PG8_BAR;
            PG8_LDB(B0, 1, 0); PG8_SCHED; PG8_LDA(At, 1, 0); PG8_STAGE(PG8_SA(0, 1), a2 + hstep, voffA);
            PG8_WAIT_L(8); PG8_BAR; PG8_WAIT_L(0); PG8_MMA(0, 0, At, B0); PG8_BAR; PG8_SCHED;
            PG8_LDB(B1, 1, 1); PG8_STAGE(PG8_SB(1, 0), b3, voffB);
            PG8_BAR; PG8_WAIT_L(0); PG8_MMA(0, 1, At, B1); PG8_BAR;
            PG8_LDA(At, 1, 1); PG8_STAGE(PG8_SA(1, 0), a3, voffA);
            PG8_BAR; PG8_WAIT_L(0); PG8_MMA(1, 0, At, B0); PG8_BAR; PG8_SCHED;
            PG8_STAGE(PG8_SB(1, 1), b3 + hstep, voffB);
            PG8_WAIT_V(6); PG8_BAR; PG8_MMA(1, 1, At, B1); PG8_BAR;
            }
        }
        if constexpr (ALIGN_EPI) { if (wr == 0) PG8_BAR; }
        if constexpr (!Epi::AFTER_DRAIN) { E(acc, cur, wr, wc, fr, fq); S.done(cur); }
        if (!has_next) break;
#pragma unroll
        for (int a = 0; a < 2; ++a)
#pragma unroll
            for (int b = 0; b < 2; ++b)
#pragma unroll
                for (int m = 0; m < 4; ++m)
#pragma unroll
                    for (int n = 0; n < 2; ++n) acc[a][b][m][n] = (f32x4){0.f, 0.f, 0.f, 0.f};
        cur = nxt; cA = nA; cB = nB; ++ui;
        if constexpr (ALIGN_EPI) { if (wr == 1) PG8_BAR; }
    }
    PG8_WAIT_V(0);
    if constexpr (!ALIGN_EPI) { if (wr == 0) PG8_BAR; }
    PG8_BAR;
    if constexpr (Epi::AFTER_DRAIN) { E.fused(acc, cur, wr, wc, fr, fq, lds, wid, lane); S.done(cur); }
#undef PG8_SA
#undef PG8_SB
#undef PG8_STAGE
#undef PG8_LDA
#undef PG8_LDB
#undef PG8_MMA
#undef PG8_WAIT_V
#undef PG8_WAIT_L
#undef PG8_BAR
#undef PG8_SCHED
}
}

#define LAS __attribute__((address_space(3)))
using pg8::bf16_t; using pg8::f32x4; using pg8::u32x4; using pg8::Unit;
typedef short bf16x8 __attribute__((ext_vector_type(8)));
typedef short s16x4 __attribute__((ext_vector_type(4)));
typedef short v4i16_t __attribute__((ext_vector_type(4)));
typedef float f32x16 __attribute__((ext_vector_type(16)));
typedef unsigned u32x2 __attribute__((ext_vector_type(2)));
typedef float f32x2_t __attribute__((ext_vector_type(2))); typedef __bf16 bf16x2_t __attribute__((ext_vector_type(2)));

constexpr int NWAVES = 8, NTHR = 512;
constexpr int DM = 1024, NB = 8, SEQ = 2048, DEPTH = 4, M = NB * SEQ;
constexpr int NHEAD = 24, MIXW = 1536, LDQ = 3 * MIXW  , NG = 3 * DM  , NQKVG = LDQ + NG  ;
constexpr int DFF = 2816, NGU = 2 * DFF;
constexpr float NORM_EPS = 1e-6f;
constexpr int LDS_BYTES = 147456;

constexpr size_t MiB = 1u << 20;
constexpr size_t WS_CTR = 0;
constexpr size_t WS_BAR = 32 * 1024;
constexpr size_t WS_MOD = 64 * 1024;
constexpr size_t WS_COS = WS_MOD + (size_t)DEPTH * NB * 6 * DM * 4;
constexpr size_t WS_SIN = WS_COS + (size_t)SEQ * 32 * 4;
constexpr size_t WS_KMEAN = WS_SIN + (size_t)SEQ * 32 * 4;
constexpr size_t WS_CNT = 2 * MiB;
constexpr size_t WS_XBUF = 2 * MiB + 256 * 1024;
constexpr size_t WS_W = 4 * MiB;
constexpr size_t W_QKVG = 0, W_A = W_QKVG + (size_t)NQKVG * DM * 2, W_B = W_A + (size_t)DM * 384 * 2, W_C = W_B + (size_t)DM * 384 * 2,
                 W_O = W_C + (size_t)DM * 384 * 2, W_GU = W_O + (size_t)DM * DM * 2, W_D = W_GU + (size_t)NGU * DM * 2, W_END = W_D + (size_t)DM * DFF * 2;
static_assert(W_END <= 40 * MiB, "weights");
constexpr size_t WS_H = 44 * MiB;
constexpr size_t WS_QKV = 76 * MiB;
constexpr size_t WS_GATES = 220 * MiB;
constexpr size_t WS_ATTA = 316 * MiB;
constexpr size_t WS_ATTB = WS_ATTA + (size_t)M * 384 * 2;
constexpr size_t WS_ATTC = WS_ATTB + (size_t)M * 384 * 2;
constexpr size_t WS_MERGED = 352 * MiB;
constexpr size_t WS_X16 = 384 * MiB;
constexpr size_t WS_END = 416 * MiB;

struct Params {
    const float *x, *c, *w_ada, *b_ada, *norm1_g, *w_in, *w_br_a, *w_br_b, *w_br_c, *w_gate, *b_gate, *w_out, *norm2_g, *w_gu, *w_down, *final_g;
    float* out; unsigned char* ws; int ph_lo, ph_hi;
};

__device__ __forceinline__ unsigned f2bf(float f) { unsigned u = __builtin_bit_cast(unsigned, f); return (u + 0x7fffu + ((u >> 16) & 1u)) >> 16; }
__device__ __forceinline__ unsigned pk2(float lo, float hi) { f32x2_t v = {lo, hi}; bf16x2_t b = __builtin_convertvector(v, bf16x2_t); return __builtin_bit_cast(unsigned, b); }
__device__ __forceinline__ float bf2f(unsigned short b) { return __uint_as_float((unsigned)b << 16); }
__device__ __forceinline__ float bflo(unsigned w) { return __uint_as_float(w << 16); }
__device__ __forceinline__ float bfhi(unsigned w) { return __uint_as_float(w & 0xffff0000u); }

template <int K> __device__ __forceinline__ float swz_xor(float v) { return __int_as_float(__builtin_amdgcn_ds_swizzle(__float_as_int(v), (K << 10) | 0x1f)); }
__device__ __forceinline__ float xor32_sum(float v) { auto rr = __builtin_amdgcn_permlane32_swap(__float_as_uint(v), __float_as_uint(v), false, false); return __uint_as_float(rr[0]) + __uint_as_float(rr[1]); }
__device__ __forceinline__ float xor32_max(float v) { auto rr = __builtin_amdgcn_permlane32_swap(__float_as_uint(v), __float_as_uint(v), false, false); return fmaxf(__uint_as_float(rr[0]), __uint_as_float(rr[1])); }
__device__ __forceinline__ float xor32_get(float v, int h) { auto rr = __builtin_amdgcn_permlane32_swap(__float_as_uint(v), __float_as_uint(v), false, false); return h == 0 ? __uint_as_float(rr[1]) : __uint_as_float(rr[0]); }
__device__ __forceinline__ float wave_sum(float v) {
    v += swz_xor<1>(v); v += swz_xor<2>(v); v += swz_xor<4>(v); v += swz_xor<8>(v); v += swz_xor<16>(v);
    return xor32_sum(v);
}
__device__ __forceinline__ float sigmoidf_(float x) { return __builtin_amdgcn_rcpf(1.0f + __expf(-x)); }


#define XB_TMO      128
#define XB_XCNT(j)  (256  + 64 * (j))
#define XB_XSUB(j)  (1280 + 64 * (j))
#define XB_XGEN(j)  (2304 + 64 * (j))
#define XB_TOP      3328
#define XB_TOPGEN   3392
#define XCD_BAR_WORDS 3456
#define XB_SPIN_CAP (1u << 22)
__device__ __forceinline__ unsigned xb_ld(unsigned* p)              { return __hip_atomic_load(p, __ATOMIC_RELAXED, __HIP_MEMORY_SCOPE_AGENT); }
__device__ __forceinline__ unsigned xb_add(unsigned* p, unsigned v) { return __hip_atomic_fetch_add(p, v, __ATOMIC_RELAXED, __HIP_MEMORY_SCOPE_AGENT); }
__device__ __forceinline__ unsigned xb_xcc_id() { return (unsigned)__builtin_amdgcn_s_getreg((3 << 11) | 20) & 0xFu; }
#define XB_SPIN(cond, bar) do { unsigned _sp = 0; while (cond) { __builtin_amdgcn_s_sleep(1); \
    if ((++_sp & 255u) == 0u) { if (xb_ld(&(bar)[XB_TMO])) break; if (_sp > XB_SPIN_CAP) { atomicAdd(&(bar)[XB_TMO], 1u); break; } } } } while (0)
struct XcdBarrier { unsigned* bar; unsigned x; volatile LAS unsigned* st; };
__device__ __forceinline__ XcdBarrier xcd_barrier_post(unsigned* bar, volatile LAS unsigned* st) {
    XcdBarrier b; b.bar = bar; b.x = xb_xcc_id(); b.st = st;
    if (threadIdx.x == 0) (void)xb_add(&bar[XB_XCNT(b.x)], 1u);
    return b;
}
__device__ __forceinline__ void xcd_barrier_complete(unsigned* bar, unsigned x, unsigned& nloc, unsigned& nx) {
    const unsigned G = gridDim.x * gridDim.y * gridDim.z;
    unsigned sum, cnt, mine, sp = 0u;
    for (;;) {
        sum = 0u; cnt = 0u; mine = 0u;
#pragma unroll
        for (unsigned j = 0; j < 16; ++j) { const unsigned c = xb_ld(&bar[XB_XCNT(j)]); sum += c; cnt += (c > 0u) ? 1u : 0u; mine = (j == x) ? c : mine; }
        if (sum == G) break;
        __builtin_amdgcn_s_sleep(1);
        if ((++sp & 255u) == 0u) { if (xb_ld(&bar[XB_TMO])) break; if (sp > XB_SPIN_CAP) { atomicAdd(&bar[XB_TMO], 1u); break; } }
    }
    nloc = mine > 0u ? mine : 1u; nx = cnt > 0u ? cnt : 1u;
}
__device__ __forceinline__ void xcd_barrier(unsigned* bar, volatile LAS unsigned* st, const int tid) {
    asm volatile("s_waitcnt vmcnt(0)" ::: "memory");
    __syncthreads();
    if (tid == 0) {
        const unsigned x = xb_xcc_id();
        __builtin_amdgcn_s_waitcnt(0);
        unsigned nloc = st[0], nx = st[1];
        if (nloc == 0u) { xcd_barrier_complete(bar, x, nloc, nx); st[0] = nloc; st[1] = nx; }
        const unsigned old = xb_add(&bar[XB_XSUB(x)], 1u);
        const unsigned gen = old / nloc;
        if (old + 1u == (gen + 1u) * nloc) {
            __builtin_amdgcn_fence(__ATOMIC_RELEASE, "agent");
            asm volatile("s_waitcnt vmcnt(0)" ::: "memory");
            const unsigned og = xb_add(&bar[XB_TOP], 1u);
            const unsigned tg = og / nx;
            if (og + 1u == (tg + 1u) * nx) xb_add(&bar[XB_TOPGEN], 1u);
            else XB_SPIN(xb_ld(&bar[XB_TOPGEN]) == tg, bar);
            __builtin_amdgcn_fence(__ATOMIC_ACQUIRE, "agent");
            xb_add(&bar[XB_XGEN(x)], 1u);
            asm volatile("s_waitcnt vmcnt(0)" ::: "memory");
        } else {
            XB_SPIN(xb_ld(&bar[XB_XGEN(x)]) == gen, bar);
            __builtin_amdgcn_fence(__ATOMIC_ACQUIRE, "agent");
            asm volatile("s_waitcnt vmcnt(0)" ::: "memory");
        }
    }
    __syncthreads();
}

struct EpiQKVG {
    static constexpr bool PERM = true, AFTER_DRAIN = false;
    bf16_t* qkv; bf16_t* gates; const float* bgate; const float* cosT; const float* sinT; float* kmean;
    __device__ __forceinline__ void operator()(const f32x4 (&acc)[2][2][4][2], const Unit& u, int wr, int wc, int fr, int fq) const {
        const int row0 = u.pm * 256 + wr * 64 + fr;
#pragma unroll
        for (int bj = 0; bj < 2; ++bj) {
            const int col = u.pn * 256 + bj * 128 + wc * 32 + 8 * fq;
            if (u.pn < 18) {
                const int which = col / MIXW, rem = col - which * MIXW, head = rem >> 6, dc = rem & 63;
                const bool rope = (which < 2) && (head < 18);
                const bool ksum_on = (which == 1) && (head >= 12) && (head < 18);
                const float sc = (which == 0) ? 0.125f * 1.4426950408889634f : 1.0f;
                if (rope) {
                    f32x4 c4[8], s4[8];
#pragma unroll
                    for (int i = 0; i < 8; ++i) { const int pos = (row0 + (i >> 2) * 128 + (i & 3) * 16) & (SEQ - 1);
                        c4[i] = *(const f32x4*)(cosT + (unsigned)(pos * 32 + (dc >> 1))); s4[i] = *(const f32x4*)(sinT + (unsigned)(pos * 32 + (dc >> 1))); }
                    float ks[8];
#pragma unroll
                    for (int j = 0; j < 8; ++j) ks[j] = 0.f;
#pragma unroll
                    for (int i = 0; i < 8; ++i) {
                        const int ai = i >> 2, m = i & 3, row = row0 + ai * 128 + m * 16;
                        const f32x4 v0 = acc[ai][bj][m][0], v1 = acc[ai][bj][m][1];
                        float r[8];
                        r[0] = v0[0] * c4[i][0] - v0[1] * s4[i][0]; r[1] = v0[0] * s4[i][0] + v0[1] * c4[i][0];
                        r[2] = v0[2] * c4[i][1] - v0[3] * s4[i][1]; r[3] = v0[2] * s4[i][1] + v0[3] * c4[i][1];
                        r[4] = v1[0] * c4[i][2] - v1[1] * s4[i][2]; r[5] = v1[0] * s4[i][2] + v1[1] * c4[i][2];
                        r[6] = v1[2] * c4[i][3] - v1[3] * s4[i][3]; r[7] = v1[2] * s4[i][3] + v1[3] * c4[i][3];
                        if (ksum_on) {
#pragma unroll
                            for (int j = 0; j < 8; ++j) ks[j] += r[j];
                        }
                        u32x4 w; w.x = pk2(r[0] * sc, r[1] * sc); w.y = pk2(r[2] * sc, r[3] * sc); w.z = pk2(r[4] * sc, r[5] * sc); w.w = pk2(r[6] * sc, r[7] * sc);
                        __builtin_nontemporal_store(w, (u32x4*)(qkv + (unsigned)(row * LDQ + col)));
                    }
                    if (ksum_on) {
#pragma unroll
                        for (int j = 0; j < 8; ++j) {
                            float v = ks[j];
                            v += swz_xor<1>(v); v += swz_xor<2>(v); v += swz_xor<4>(v); v += swz_xor<8>(v);
                            ks[j] = v;
                        }
                        if (fr == 0) {
                            float* dst = kmean + (size_t)(((u.pm >> 3) * 6 + (head - 12)) * 8 + (u.pm & 7)) * 64 + dc;
#pragma unroll
                            for (int j = 0; j < 8; ++j) atomicAdd(dst + j, ks[j]);
                        }
                    }
                } else {
#pragma unroll
                    for (int i = 0; i < 8; ++i) {
                        const int ai = i >> 2, m = i & 3, row = row0 + ai * 128 + m * 16;
                        const f32x4 v0 = acc[ai][bj][m][0] * sc, v1 = acc[ai][bj][m][1] * sc;
                        u32x4 w; w.x = pk2(v0[0], v0[1]); w.y = pk2(v0[2], v0[3]); w.z = pk2(v1[0], v1[1]); w.w = pk2(v1[2], v1[3]);
                        __builtin_nontemporal_store(w, (u32x4*)(qkv + (unsigned)(row * LDQ + col)));
                    }
                }
            } else {
                const int gcol = col - LDQ;
                const f32x4 b0 = *(const f32x4*)(bgate + gcol), b1 = *(const f32x4*)(bgate + gcol + 4);
#pragma unroll
                for (int ai = 0; ai < 2; ++ai)
#pragma unroll
                    for (int m = 0; m < 4; ++m) {
                        const int row = row0 + ai * 128 + m * 16;
                        const f32x4 v0 = acc[ai][bj][m][0] + b0, v1 = acc[ai][bj][m][1] + b1;
                        u32x4 w; w.x = pk2(sigmoidf_(v0[0]), sigmoidf_(v0[1])); w.y = pk2(sigmoidf_(v0[2]), sigmoidf_(v0[3]));
                        w.z = pk2(sigmoidf_(v1[0]), sigmoidf_(v1[1])); w.w = pk2(sigmoidf_(v1[2]), sigmoidf_(v1[3]));
                        __builtin_nontemporal_store(w, (u32x4*)(gates + (unsigned)(row * NG + gcol)));
                    }
            }
            asm volatile("" ::: "memory");
        }
    }
};
struct EpiBranch {
    static constexpr bool PERM = true, AFTER_DRAIN = false;
    const bf16_t* gates; bf16_t* merged;
    __device__ __forceinline__ void operator()(const f32x4 (&acc)[2][2][4][2], const Unit& us, int wr, int wc, int fr, int fq) const {
        const int br = us.pm >> 6; Unit u; u.pm = us.pm & 63; u.pn = us.pn & 3;
        const int row0 = u.pm * 256 + wr * 64 + fr;
#pragma unroll
        for (int ai = 0; ai < 2; ++ai)
#pragma unroll
            for (int m = 0; m < 4; ++m) {
                const int row = row0 + ai * 128 + m * 16;
#pragma unroll
                for (int bj = 0; bj < 2; ++bj) {
                    const int col = u.pn * 256 + bj * 128 + wc * 32 + 8 * fq;
                    const u32x4 g = *(const u32x4*)(gates + (unsigned)(row * NG + br * DM + col));
                    const f32x4 v0 = acc[ai][bj][m][0], v1 = acc[ai][bj][m][1];
                    float o[8];
                    o[0] = bflo(g.x) * v0[0]; o[1] = bfhi(g.x) * v0[1]; o[2] = bflo(g.y) * v0[2]; o[3] = bfhi(g.y) * v0[3];
                    o[4] = bflo(g.z) * v1[0]; o[5] = bfhi(g.z) * v1[1]; o[6] = bflo(g.w) * v1[2]; o[7] = bfhi(g.w) * v1[3];
                    bf16_t* dst = merged + (unsigned)(row * DM + col);
                    if (br > 0) {
                        const u32x4 p = *(const u32x4*)dst;
                        o[0] += bflo(p.x); o[1] += bfhi(p.x); o[2] += bflo(p.y); o[3] += bfhi(p.y);
                        o[4] += bflo(p.z); o[5] += bfhi(p.z); o[6] += bflo(p.w); o[7] += bfhi(p.w);
                    }
                    u32x4 w; w.x = pk2(o[0], o[1]); w.y = pk2(o[2], o[3]); w.z = pk2(o[4], o[5]); w.w = pk2(o[6], o[7]);
                    *(u32x4*)dst = w;
                }
                asm volatile("" ::: "memory");
            }
    }
};
struct RowStats {
    unsigned* xbuf;
    unsigned* cnt;
    __device__ __forceinline__ void run(const f32x4 (&v)[2][2][4][2], const Unit& u, int wr, int wc, int fr, int fq, LAS unsigned char* lds, int wid, int lane) const {
        LAS float* P = (LAS float*)lds;
        LAS float* S = (LAS float*)(lds + 4096);
#pragma unroll
        for (int ai = 0; ai < 2; ++ai)
#pragma unroll
            for (int m = 0; m < 4; ++m) {
                float q = 0.f;
#pragma unroll
                for (int bj = 0; bj < 2; ++bj)
#pragma unroll
                    for (int n = 0; n < 2; ++n) { const f32x4 x = v[ai][bj][m][n]; q += (x[0] * x[0] + x[1] * x[1]) + (x[2] * x[2] + x[3] * x[3]); }
                q += swz_xor<16>(q); q = xor32_sum(q);
                if (fq == 0) P[(ai * 128 + wr * 64 + m * 16 + fr) * 4 + wc] = q;
            }
        asm volatile("s_waitcnt lgkmcnt(0)" ::: "memory"); __builtin_amdgcn_s_barrier(); asm volatile("" ::: "memory");
        const int row = wid * 32 + (lane & 31);
        if (lane < 32) {
            const float t = (P[row * 4 + 0] + P[row * 4 + 1]) + (P[row * 4 + 2] + P[row * 4 + 3]);
            __hip_atomic_store(xbuf + ((size_t)(u.pm * 256 + row) * 4 + u.pn), __float_as_uint(t), __ATOMIC_RELAXED, __HIP_MEMORY_SCOPE_AGENT);
        }
        asm volatile("s_waitcnt vmcnt(0)" ::: "memory");
        if (lane == 0) __hip_atomic_fetch_add(cnt + 64 * u.pm, 1u, __ATOMIC_RELAXED, __HIP_MEMORY_SCOPE_AGENT);
        if (wid == 0) {
            unsigned sp = 0;
            for (;;) {
                if ((unsigned)__builtin_amdgcn_readfirstlane((int)__hip_atomic_load(cnt + 64 * u.pm, __ATOMIC_RELAXED, __HIP_MEMORY_SCOPE_AGENT)) >= 32u) break;
                if (++sp > (1u << 22)) break;
                __builtin_amdgcn_s_sleep(2);
            }
            __builtin_amdgcn_fence(__ATOMIC_ACQUIRE, "agent");
        }
        asm volatile("s_waitcnt vmcnt(0) lgkmcnt(0)" ::: "memory"); __builtin_amdgcn_s_barrier(); asm volatile("" ::: "memory");
        if (lane < 32) {
            const unsigned* slot = xbuf + (size_t)(u.pm * 256 + row) * 4;
            float t = 0.f;
#pragma unroll
            for (int k = 0; k < 4; ++k) t += __uint_as_float(__hip_atomic_load(slot + k, __ATOMIC_RELAXED, __HIP_MEMORY_SCOPE_AGENT));
            S[row] = 1.0f / sqrtf(t * (1.0f / DM) + NORM_EPS);
        }
        asm volatile("s_waitcnt lgkmcnt(0)" ::: "memory"); __builtin_amdgcn_s_barrier(); asm volatile("" ::: "memory");
    }
};
struct EpiResidNorm {
    static constexpr bool PERM = true, AFTER_DRAIN = true;
    const float* xin32; const bf16_t* xin16; bf16_t* xout16; float* yout; const float* gate; bf16_t* hout; const float* ng; const float* sc; const float* sh; RowStats st; int mode;
    __device__ __forceinline__ void operator()(const f32x4 (&)[2][2][4][2], const Unit&, int, int, int, int) const {}
    __device__ __forceinline__ void fused(f32x4 (&acc)[2][2][4][2], const Unit& u, int wr, int wc, int fr, int fq, LAS unsigned char* lds, int wid, int lane) const {
        const int row0 = u.pm * 256 + wr * 64 + fr;
        const unsigned boff = (unsigned)((u.pm >> 3) * 6 * DM);
#pragma unroll
        for (int bj = 0; bj < 2; ++bj) {
            const int col = u.pn * 256 + bj * 128 + wc * 32 + 8 * fq;
            const f32x4 g0 = *(const f32x4*)(gate + boff + col), g1 = *(const f32x4*)(gate + boff + col + 4);
            if (xin32) {
#pragma unroll
                for (int ai = 0; ai < 2; ++ai)
#pragma unroll
                    for (int m = 0; m < 4; ++m) {
                        const float* xp = xin32 + (unsigned)((row0 + ai * 128 + m * 16) * DM + col);
                        const f32x4 x0 = *(const f32x4*)xp, x1 = *(const f32x4*)(xp + 4);
                        acc[ai][bj][m][0] = x0 + g0 * acc[ai][bj][m][0]; acc[ai][bj][m][1] = x1 + g1 * acc[ai][bj][m][1];
                        asm volatile("" : "+v"(acc[ai][bj][m][0]), "+v"(acc[ai][bj][m][1]));
                        if (m & 1) asm volatile("" ::: "memory");
                    }
            } else {
#pragma unroll
                for (int ai = 0; ai < 2; ++ai)
#pragma unroll
                    for (int m = 0; m < 4; ++m) {
                        const u32x4 xw = *(const u32x4*)(xin16 + (unsigned)((row0 + ai * 128 + m * 16) * DM + col));
                        const f32x4 x0 = (f32x4){bflo(xw.x), bfhi(xw.x), bflo(xw.y), bfhi(xw.y)}, x1 = (f32x4){bflo(xw.z), bfhi(xw.z), bflo(xw.w), bfhi(xw.w)};
                        acc[ai][bj][m][0] = x0 + g0 * acc[ai][bj][m][0]; acc[ai][bj][m][1] = x1 + g1 * acc[ai][bj][m][1];
                        asm volatile("" : "+v"(acc[ai][bj][m][0]), "+v"(acc[ai][bj][m][1]));
                    }
            }
            asm volatile("" ::: "memory");
        }
        st.run(acc, u, wr, wc, fr, fq, lds, wid, lane);
        const LAS float* S = (const LAS float*)(lds + 4096);
#pragma unroll
        for (int bj = 0; bj < 2; ++bj) {
            const int col = u.pn * 256 + bj * 128 + wc * 32 + 8 * fq;
            f32x4 gv0 = *(const f32x4*)(ng + col), gv1 = *(const f32x4*)(ng + col + 4), sh0 = (f32x4){0.f, 0.f, 0.f, 0.f}, sh1 = sh0;
            if (mode == 0) { gv0 = gv0 * (*(const f32x4*)(sc + boff + col) + 1.0f); gv1 = gv1 * (*(const f32x4*)(sc + boff + col + 4) + 1.0f);
                             sh0 = *(const f32x4*)(sh + boff + col); sh1 = *(const f32x4*)(sh + boff + col + 4); }
#pragma unroll
            for (int ai = 0; ai < 2; ++ai)
#pragma unroll
                for (int m = 0; m < 4; ++m) {
                    const int r = ai * 128 + wr * 64 + m * 16 + fr;
                    const unsigned off = (unsigned)((u.pm * 256 + r) * DM + col);
                    const f32x4 x0 = acc[ai][bj][m][0], x1 = acc[ai][bj][m][1];
                    const float rs = S[r];
                    const f32x4 y0 = x0 * rs * gv0 + sh0, y1 = x1 * rs * gv1 + sh1;
                    if (mode == 0) {
                        u32x4 xw; xw.x = pk2(x0[0], x0[1]); xw.y = pk2(x0[2], x0[3]); xw.z = pk2(x1[0], x1[1]); xw.w = pk2(x1[2], x1[3]);
                        *(u32x4*)(xout16 + off) = xw;
                        u32x4 hw; hw.x = pk2(y0[0], y0[1]); hw.y = pk2(y0[2], y0[3]); hw.z = pk2(y1[0], y1[1]); hw.w = pk2(y1[2], y1[3]);
                        *(u32x4*)(hout + off) = hw;
                    } else {
                        *(f32x4*)(yout + off) = y0; *(f32x4*)(yout + off + 4) = y1;
                    }
                    if (m & 1) asm volatile("" ::: "memory");
                }
        }
    }
};
struct EpiSwiGLU {
    static constexpr bool PERM = true, AFTER_DRAIN = false;
    bf16_t* act;
    __device__ __forceinline__ void operator()(const f32x4 (&acc)[2][2][4][2], const Unit& u, int wr, int wc, int fr, int fq) const {
        const int row0 = u.pm * 256 + wr * 64 + fr;
        const int col = u.pn * 128 + wc * 32 + 8 * fq;
#pragma unroll
        for (int ai = 0; ai < 2; ++ai)
#pragma unroll
            for (int m = 0; m < 4; ++m) {
                const int row = row0 + ai * 128 + m * 16;
                float o[8];
#pragma unroll
                for (int n = 0; n < 2; ++n)
#pragma unroll
                    for (int j = 0; j < 4; ++j) { const float gt = acc[ai][0][m][n][j], up = acc[ai][1][m][n][j]; o[4 * n + j] = gt * sigmoidf_(gt) * up; }
                u32x4 w; w.x = pk2(o[0], o[1]); w.y = pk2(o[2], o[3]); w.z = pk2(o[4], o[5]); w.w = pk2(o[6], o[7]);
                __builtin_nontemporal_store(w, (u32x4*)(act + (unsigned)(row * DFF + col)));
                asm volatile("" ::: "memory");
            }
    }
};

struct BranchOrder {
    pg8::StaticOrder base;
    __device__ __forceinline__ bool next(int i, Unit& u) const { Unit t; if (!base.next(i / 3, t)) return false; const int br = i % 3; u.pm = br * 64 + t.pm; u.pn = br * 4 + t.pn; return true; }
    __device__ __forceinline__ void a_ready(const Unit&) const {}
    __device__ __forceinline__ void done(const Unit&) const {}
};
struct LimitOrder {
    pg8::StaticOrder base; int lim;
    __device__ __forceinline__ bool next(int i, Unit& u) const { return i < lim && base.next(i, u); }
    __device__ __forceinline__ void a_ready(const Unit&) const {}
    __device__ __forceinline__ void done(const Unit&) const {}
};
struct OneUnit {
    Unit u0;
    __device__ __forceinline__ bool next(int i, Unit& u) const { if (i != 0) return false; u = u0; return true; }
    __device__ __forceinline__ void a_ready(const Unit&) const {}
    __device__ __forceinline__ void done(const Unit&) const {}
};
__device__ __forceinline__ int rowmap(int kind, int n) {
    if (kind == 1) { const int which = n / MIXW, rem = n - which * MIXW, head = rem >> 6, d = rem & 63;
        const int dd = (which < 2 && head < 18) ? (2 * (d & 31) + (d >> 5)) : d; return which * MIXW + head * 64 + dd; }
    if (kind == 2) { const int up = n >= DFF, j = up ? n - DFF : n; return (j >> 7) * 256 + up * 128 + (j & 127); }
    return n;
}
__device__ __forceinline__ void transpose_item(const float* W, int K, int N, bf16_t* WT, int ldk, int row_off, int kind, LAS float* scr, int item, int lane) {
    const int nblk = N / 32, kb = item / nblk, nb = item % nblk, k0 = 64 * kb, n0 = 32 * nb;
#pragma unroll 8
    for (int i = 0; i < 32; ++i) { const int kk = 2 * i + (lane >> 5); scr[kk * 33 + (lane & 31)] = W[(size_t)(k0 + kk) * N + n0 + (lane & 31)]; }
    asm volatile("s_waitcnt lgkmcnt(0)" ::: "memory");
    const int c = lane & 7;
#pragma unroll
    for (int j = 0; j < 4; ++j) { const int n = (lane >> 3) + 8 * j; const LAS float* s = scr + (8 * c) * 33 + n;
        u32x4 o; o.x = pk2(s[0 * 33], s[1 * 33]); o.y = pk2(s[2 * 33], s[3 * 33]); o.z = pk2(s[4 * 33], s[5 * 33]); o.w = pk2(s[6 * 33], s[7 * 33]);
        *(u32x4*)(WT + (size_t)(row_off + rowmap(kind, n0 + n)) * ldk + k0 + 8 * c) = o; }
    asm volatile("s_waitcnt lgkmcnt(0)" ::: "memory");
}

#define MFMA32(a, b, c) __builtin_amdgcn_mfma_f32_32x32x16_bf16((a), (b), (c), 0, 0, 0)
constexpr int VROW = 144;
constexpr int VTILE = 32 * VROW;
__device__ __forceinline__ int crow(int r, int h) { return (r & 3) + 8 * (r >> 2) + 4 * h; }
__device__ __forceinline__ s16x4 vtr(const LAS unsigned char* p) { return __builtin_bit_cast(s16x4, __builtin_amdgcn_ds_read_tr16_b64_v4i16((LAS v4i16_t*)p)); }

struct WaveCtx { int lane, q, h; LAS unsigned char* vl; int troff; };

__device__ __forceinline__ void load_q(bf16x8 (&qf)[4], const bf16_t* qrow, int h) {
#pragma unroll
    for (int ks = 0; ks < 4; ++ks) qf[ks] = *(const bf16x8*)(qrow + 16 * ks + 8 * h);
}
template <bool CLAMP>
__device__ __forceinline__ void load_k(bf16x8 (&kf)[4], const bf16_t* kbase, int k0, int kst, const WaveCtx& c) {
    int kp = k0 + kst * c.q; if (CLAMP) kp = kp < 0 ? 0 : (kp > SEQ - 1 ? SEQ - 1 : kp);
    const bf16_t* kr = kbase + (size_t)kp * LDQ + 8 * c.h;
#pragma unroll
    for (int ks = 0; ks < 4; ++ks) kf[ks] = *(const bf16x8*)(kr + 16 * ks);
}
template <bool CLAMP>
__device__ __forceinline__ void load_v(u32x4 (&vr)[4], const bf16_t* vbase, int k0, int kst, const WaveCtx& c) {
#pragma unroll
    for (int i = 0; i < 4; ++i) { const int p = c.lane + 64 * i, n = p >> 3; int kp = k0 + kst * n; if (CLAMP) kp = kp < 0 ? 0 : (kp > SEQ - 1 ? SEQ - 1 : kp);
        vr[i] = *(const u32x4*)(vbase + (size_t)kp * LDQ + (p & 7) * 8); }
}
__device__ __forceinline__ void store_v(const u32x4 (&vr)[4], const WaveCtx& c) {
#pragma unroll
    for (int i = 0; i < 4; ++i) { const int p = c.lane + 64 * i, n = p >> 3; *(LAS u32x4*)(c.vl + n * VROW + (p & 7) * 16) = vr[i]; }
}
struct VF { bf16x8 v[2][2]; };
__device__ __forceinline__ void read_vf_at(VF& f, const LAS unsigned char* vb, const WaveCtx& c) {
#pragma unroll
    for (int dt = 0; dt < 2; ++dt)
#pragma unroll
        for (int s2 = 0; s2 < 2; ++s2) {
            const LAS unsigned char* a = vb + c.troff + (16 * s2) * VROW + dt * 64;
            const s16x4 lo = vtr(a), hi = vtr(a + 8 * VROW);
            f.v[dt][s2] = (bf16x8){lo[0], lo[1], lo[2], lo[3], hi[0], hi[1], hi[2], hi[3]};
        }
}
__device__ __forceinline__ void read_vf(VF& f, const WaveCtx& c) {
#pragma unroll
    for (int dt = 0; dt < 2; ++dt)
#pragma unroll
        for (int s2 = 0; s2 < 2; ++s2) {
            const LAS unsigned char* a = c.vl + c.troff + (16 * s2) * VROW + dt * 64;
            const s16x4 lo = vtr(a), hi = vtr(a + 8 * VROW);
            f.v[dt][s2] = (bf16x8){lo[0], lo[1], lo[2], lo[3], hi[0], hi[1], hi[2], hi[3]};
        }
}
__device__ __forceinline__ void pv(f32x16 (&o)[2], const f32x16& p, const VF& f) {
    bf16x8 pb[2];
#pragma unroll
    for (int s2 = 0; s2 < 2; ++s2) {
        u32x4 w; w.x = pk2(p[8 * s2 + 0], p[8 * s2 + 1]); w.y = pk2(p[8 * s2 + 2], p[8 * s2 + 3]); w.z = pk2(p[8 * s2 + 4], p[8 * s2 + 5]); w.w = pk2(p[8 * s2 + 6], p[8 * s2 + 7]);
        pb[s2] = __builtin_bit_cast(bf16x8, w);
    }
#pragma unroll
    for (int s2 = 0; s2 < 2; ++s2)
#pragma unroll
        for (int dt = 0; dt < 2; ++dt) o[dt] = MFMA32(f.v[dt][s2], pb[s2], o[dt]);
}
__device__ __forceinline__ f32x16 qk(const bf16x8 (&kf)[4], const bf16x8 (&qf)[4]) {
    f32x16 s0, s1;
#pragma unroll
    for (int r = 0; r < 16; ++r) { s0[r] = 0.f; s1[r] = 0.f; }
    s0 = MFMA32(kf[0], qf[0], s0); s1 = MFMA32(kf[2], qf[2], s1);
    s0 = MFMA32(kf[1], qf[1], s0); s1 = MFMA32(kf[3], qf[3], s1);
    return s0 + s1;
}
__device__ __forceinline__ f32x16 qk_ref(const bf16x8 (&kf)[4], const bf16x8 (&qf)[4], const f32x16& negm) {
    f32x16 s = MFMA32(kf[0], qf[0], negm);
    s = MFMA32(kf[1], qf[1], s); s = MFMA32(kf[2], qf[2], s); s = MFMA32(kf[3], qf[3], s);
    return s;
}
struct SoftState { f32x16 o[2]; f32x16 negm; float m, l; };
struct KV { bf16x8 kf[4]; u32x4 vr[4]; };
template <bool CLAMP>
__device__ __forceinline__ void issue_kv(KV& t, const bf16_t* kbase, const bf16_t* vbase, int k0, int kst, const WaveCtx& c) { load_k<CLAMP>(t.kf, kbase, k0, kst, c); load_v<CLAMP>(t.vr, vbase, k0, kst, c); }
__device__ __forceinline__ void soft_init(SoftState& st) {
#pragma unroll
    for (int r = 0; r < 16; ++r) { st.o[0][r] = 0.f; st.o[1][r] = 0.f; }
    st.m = 0.f; st.l = 0.f;
#pragma unroll
    for (int r = 0; r < 16; ++r) st.negm[r] = 0.f;
}
template <int MODE>
__device__ __forceinline__ void soft_compute(SoftState& st, const bf16x8 (&qf)[4], const KV& t, int k0, int kst, int qp, int W, int dilm1, bool lane_ok, bool diag, const WaveCtx& c) {
    store_v(t.vr, c);
    VF vf; read_vf(vf, c);
    f32x16 s = qk_ref(t.kf, qf, st.negm);
    if (MODE == 0) {
        const int relb = qp - k0;
        const bool cls_ok = ((relb & dilm1) == 0);
#pragma unroll
        for (int r = 0; r < 16; ++r) {
            const unsigned rel = (unsigned)(relb - kst * crow(r, c.h));
            s[r] = (cls_ok && rel <= (unsigned)W) ? s[r] : -1e30f;
        }

    } else if (diag) {
#pragma unroll
        for (int r = 0; r < 16; ++r) { const int kp = k0 + crow(r, c.h); s[r] = (kp <= qp) ? s[r] : -1e30f; }
    } else if (__ballot(!lane_ok) != 0ull) {
#pragma unroll
        for (int r = 0; r < 16; ++r) s[r] = lane_ok ? s[r] : -1e30f;
    }
    float mx = fmaxf(fmaxf(s[0], s[1]), fmaxf(s[2], s[3]));
#pragma unroll
    for (int r = 4; r < 16; r += 4) mx = fmaxf(mx, fmaxf(fmaxf(s[r], s[r + 1]), fmaxf(s[r + 2], s[r + 3])));
    mx = xor32_max(mx);
    if (__ballot(mx > 8.0f) != 0ull) {
        const float d = fmaxf(mx, 0.f), scl = __builtin_amdgcn_exp2f(-d);
        st.l *= scl; st.m += d;
        const float nm = -st.m;
#pragma unroll
        for (int r = 0; r < 16; ++r) { st.o[0][r] *= scl; st.o[1][r] *= scl; s[r] -= d; st.negm[r] = nm; }
    }
    float ps = 0.f;
#pragma unroll
    for (int r = 0; r < 16; ++r) { const float p = __builtin_amdgcn_exp2f(s[r]); s[r] = p; ps += p; }
    st.l += xor32_sum(ps);
    pv(st.o, s, vf);
}
__device__ __forceinline__ void store_o(const f32x16 (&o)[2], float inv, bf16_t* orow, const WaveCtx& c) {
#pragma unroll
    for (int dt = 0; dt < 2; ++dt)
#pragma unroll
        for (int r4 = 0; r4 < 4; ++r4) {
            u32x2 w; w.x = pk2(o[dt][4 * r4] * inv, o[dt][4 * r4 + 1] * inv); w.y = pk2(o[dt][4 * r4 + 2] * inv, o[dt][4 * r4 + 3] * inv);
            *(u32x2*)(orow + 32 * dt + 8 * r4 + 4 * c.h) = w;
        }
}

__device__ __forceinline__ void unit_A(const bf16_t* qkv, bf16_t* outA, int b, int slot, int blk, int w, const WaveCtx& c) {
    const int cls0 = (w & 3) + 8 * (w >> 2), cls = cls0 + 4 * (c.q >> 4), qp = 256 * blk + cls + 16 * (c.q & 15);
    const bf16_t* rowb = qkv + (size_t)b * SEQ * LDQ;
    SoftState st; soft_init(st);
    for (int g = 0; g < 3; ++g) {
        const int dil = 1 << (2 * g), W = 128 * dil, head = 4 * g + slot;
        bf16x8 qf[4]; load_q(qf, rowb + (size_t)qp * LDQ + head * 64, c.h);
        const bf16_t* kbase = rowb + MIXW + head * 64; const bf16_t* vbase = rowb + 2 * MIXW + head * 64;
        int ks0, ks1 = 0, n0, n1 = 0;
        if (g == 0) { ks0 = 256 * blk + cls0 - 128; if (ks0 < 0) ks0 = 0; const int kend = 256 * blk + cls0 + 4 + 240; n0 = ((kend - ks0) + 1 + 31) >> 5; }
        else if (g == 1) {
            const int lo = 256 * blk - W;
            ks0 = (lo < 0) ? (cls0 & 3) : (cls0 + lo);
            n0 = ((256 * blk + cls0 + 4 + 240 - ks0) / dil + 1 + 31) >> 5;
        } else {
            const int lo = 256 * blk - W;
            const int c0 = cls0, c1 = cls0 + 4;
            ks0 = (lo < 0) ? (c0 & (dil - 1)) : (c0 + lo); ks1 = (lo < 0) ? (c1 & (dil - 1)) : (c1 + lo);
            n0 = ((256 * blk + c0 + 240 - ks0) / dil + 1 + 31) >> 5; n1 = ((256 * blk + c1 + 240 - ks1) / dil + 1 + 31) >> 5;
        }
        const int ntot = n0 + n1, step = 32 * dil;
        KV ta, tb;
        issue_kv<true>(ta, kbase, vbase, ks0, dil, c);
#define A_K0(i) (((i) < n0) ? (ks0 + step * (i)) : (ks1 + step * ((i) - n0)))
        for (int i = 0; i < ntot; i += 2) {
            if (i + 1 < ntot) issue_kv<true>(tb, kbase, vbase, A_K0(i + 1), dil, c);
            soft_compute<0>(st, qf, ta, A_K0(i), dil, qp, W, dil - 1, true, false, c);
            if (i + 1 >= ntot) break;
            if (i + 2 < ntot) issue_kv<true>(ta, kbase, vbase, A_K0(i + 2), dil, c);
            soft_compute<0>(st, qf, tb, A_K0(i + 1), dil, qp, W, dil - 1, true, false, c);
        }
#undef A_K0
    }
    store_o(st.o, __builtin_amdgcn_rcpf(st.l), outA + (size_t)(b * SEQ + qp) * 384 + slot * 64, c);
}
constexpr int A2_T = 40960, A2_STRIDE = 68, A2_M = A2_T + 256 * A2_STRIDE * 4, A2_L = A2_M + 1024;
__device__ __forceinline__ void unit_A2(const bf16_t* qkv, bf16_t* outA, int b, int slot, int blk, int w, LAS unsigned char* lds, const WaveCtx& c) {
    const bf16_t* rowb = qkv + (size_t)b * SEQ * LDQ;
    SoftState st; soft_init(st);
    {
        const int qp1 = 256 * blk + 32 * w + c.q, head = slot;
        bf16x8 qf[4]; load_q(qf, rowb + (size_t)qp1 * LDQ + head * 64, c.h);
        const bf16_t* kbase = rowb + MIXW + head * 64; const bf16_t* vbase = rowb + 2 * MIXW + head * 64;
        int ks0 = 256 * blk + 32 * w - 128; if (ks0 < 0) ks0 = 0;
        const int ntot = ((256 * blk + 32 * w + 31 - ks0) + 1 + 31) >> 5;
        KV ta, tb;
        issue_kv<true>(ta, kbase, vbase, ks0, 1, c);
        for (int i = 0; i < ntot; i += 2) {
            if (i + 1 < ntot) issue_kv<true>(tb, kbase, vbase, ks0 + 32 * (i + 1), 1, c);
            soft_compute<0>(st, qf, ta, ks0 + 32 * i, 1, qp1, 128, 0, true, false, c);
            if (i + 1 >= ntot) break;
            if (i + 2 < ntot) issue_kv<true>(ta, kbase, vbase, ks0 + 32 * (i + 2), 1, c);
            soft_compute<0>(st, qf, tb, ks0 + 32 * (i + 1), 1, qp1, 128, 0, true, false, c);
        }
    }
    LAS float* T = (LAS float*)(lds + A2_T); LAS float* Mt = (LAS float*)(lds + A2_M); LAS float* Lt = (LAS float*)(lds + A2_L);
    {
        const int qi = 32 * w + c.q;
#pragma unroll
        for (int dt = 0; dt < 2; ++dt)
#pragma unroll
            for (int r4 = 0; r4 < 4; ++r4)
                *(LAS f32x4*)(T + qi * A2_STRIDE + 32 * dt + 8 * r4 + 4 * c.h) = (f32x4){st.o[dt][4 * r4], st.o[dt][4 * r4 + 1], st.o[dt][4 * r4 + 2], st.o[dt][4 * r4 + 3]};
        if (c.h == 0) { Mt[qi] = st.m; Lt[qi] = st.l; }
    }
    __syncthreads();
    const int cls0 = (w & 3) + 8 * (w >> 2), cls = cls0 + 4 * (c.q >> 4), qi2 = cls + 16 * (c.q & 15), qp = 256 * blk + qi2;
    {
#pragma unroll
        for (int dt = 0; dt < 2; ++dt)
#pragma unroll
            for (int r4 = 0; r4 < 4; ++r4) {
                const f32x4 v = *(const LAS f32x4*)(T + qi2 * A2_STRIDE + 32 * dt + 8 * r4 + 4 * c.h);
                st.o[dt][4 * r4] = v[0]; st.o[dt][4 * r4 + 1] = v[1]; st.o[dt][4 * r4 + 2] = v[2]; st.o[dt][4 * r4 + 3] = v[3];
            }
        st.m = Mt[qi2]; st.l = Lt[qi2];
        const float nm = -st.m;
#pragma unroll
        for (int r = 0; r < 16; ++r) st.negm[r] = nm;
    }
    for (int g = 1; g < 3; ++g) {
        const int dil = 1 << (2 * g), W = 128 * dil, head = 4 * g + slot;
        bf16x8 qf[4]; load_q(qf, rowb + (size_t)qp * LDQ + head * 64, c.h);
        const bf16_t* kbase = rowb + MIXW + head * 64; const bf16_t* vbase = rowb + 2 * MIXW + head * 64;
        int ks0, ks1 = 0, n0, n1 = 0;
        const int lo = 256 * blk - W;
        if (g == 1) { ks0 = (lo < 0) ? (cls0 & 3) : (cls0 + lo); n0 = ((256 * blk + cls0 + 4 + 240 - ks0) / dil + 1 + 31) >> 5; }
        else { const int c0 = cls0, c1 = cls0 + 4;
            ks0 = (lo < 0) ? (c0 & (dil - 1)) : (c0 + lo); ks1 = (lo < 0) ? (c1 & (dil - 1)) : (c1 + lo);
            n0 = ((256 * blk + c0 + 240 - ks0) / dil + 1 + 31) >> 5; n1 = ((256 * blk + c1 + 240 - ks1) / dil + 1 + 31) >> 5; }
        const int ntot = n0 + n1, step = 32 * dil;
        KV ta, tb;
        issue_kv<true>(ta, kbase, vbase, ks0, dil, c);
#define A_K0(i) (((i) < n0) ? (ks0 + step * (i)) : (ks1 + step * ((i) - n0)))
        for (int i = 0; i < ntot; i += 2) {
            if (i + 1 < ntot) issue_kv<true>(tb, kbase, vbase, A_K0(i + 1), dil, c);
            soft_compute<0>(st, qf, ta, A_K0(i), dil, qp, W, dil - 1, true, false, c);
            if (i + 1 >= ntot) break;
            if (i + 2 < ntot) issue_kv<true>(ta, kbase, vbase, A_K0(i + 2), dil, c);
            soft_compute<0>(st, qf, tb, A_K0(i + 1), dil, qp, W, dil - 1, true, false, c);
        }
#undef A_K0
    }
    store_o(st.o, __builtin_amdgcn_rcpf(st.l), outA + (size_t)(b * SEQ + qp) * 384 + slot * 64, c);
}
__device__ __forceinline__ void soft_compute_lds(SoftState& st, const bf16x8 (&qf)[4], const LAS unsigned char* kc, const LAS unsigned char* vc, int k0, int qp, bool lane_ok, bool diag, const WaveCtx& c) {
    bf16x8 kf[4];
#pragma unroll
    for (int ks = 0; ks < 4; ++ks) kf[ks] = *(const LAS bf16x8*)(kc + c.q * VROW + ks * 32 + c.h * 16);
    f32x16 s = qk_ref(kf, qf, st.negm);
    if (diag) {
#pragma unroll
        for (int r = 0; r < 16; ++r) { const int kp = k0 + crow(r, c.h); s[r] = (kp <= qp) ? s[r] : -1e30f; }
    } else if (__ballot(!lane_ok) != 0ull) {
#pragma unroll
        for (int r = 0; r < 16; ++r) s[r] = lane_ok ? s[r] : -1e30f;
    }
    float mx = fmaxf(fmaxf(s[0], s[1]), fmaxf(s[2], s[3]));
#pragma unroll
    for (int r = 4; r < 16; r += 4) mx = fmaxf(mx, fmaxf(fmaxf(s[r], s[r + 1]), fmaxf(s[r + 2], s[r + 3])));
    mx = xor32_max(mx);
    if (__ballot(mx > 8.0f) != 0ull) {
        const float d = fmaxf(mx, 0.f), scl = __builtin_amdgcn_exp2f(-d);
        st.l *= scl; st.m += d;
        const float nm = -st.m;
#pragma unroll
        for (int r = 0; r < 16; ++r) { st.o[0][r] *= scl; st.o[1][r] *= scl; s[r] -= d; st.negm[r] = nm; }
    }
    float ps = 0.f;
#pragma unroll
    for (int r = 0; r < 16; ++r) { const float p = __builtin_amdgcn_exp2f(s[r]); s[r] = p; ps += p; }
    st.l += xor32_sum(ps);
    VF vf; read_vf_at(vf, vc, c);
    pv(st.o, s, vf);
}
constexpr int BST = 128 * VROW;
__device__ __forceinline__ void wg_unit_B(const bf16_t* qkv, const float* kmean, bf16_t* outB, int b, int hb, int qb, LAS unsigned char* lds, int wid, const WaveCtx& c, int tid) {
    const int own = qb, qt = 8 * qb + wid, qp = 32 * qt + c.q, head = 12 + hb;
    const bf16_t* rowb = qkv + (size_t)b * SEQ * LDQ;
    bf16x8 qf[4]; load_q(qf, rowb + (size_t)qp * LDQ + head * 64, c.h);
    const bf16_t* kbase = rowb + MIXW + head * 64; const bf16_t* vbase = rowb + 2 * MIXW + head * 64;
    float gate[7];
#pragma unroll
    for (int n = 0; n < 7; ++n) {
        gate[n] = -INFINITY;
        if (n < own) {
            const float* km = kmean + (size_t)((b * 6 + hb) * 8 + n) * 64 + 8 * c.h;
            float a = 0.f;
#pragma unroll
            for (int ks = 0; ks < 4; ++ks) {
                const f32x4 k0 = *(const f32x4*)(km + 16 * ks), k1 = *(const f32x4*)(km + 16 * ks + 4);
#pragma unroll
                for (int j = 0; j < 4; ++j) { a += bf2f((unsigned short)qf[ks][j]) * k0[j]; a += bf2f((unsigned short)qf[ks][4 + j]) * k1[j]; }
            }
            a = xor32_sum(a);
            gate[n] = a;
        }
    }
    unsigned sel = 0;
#pragma unroll
    for (int n = 0; n < 7; ++n) {
        if (n < own) {
            int rank = 0;
#pragma unroll
            for (int m2 = 0; m2 < 7; ++m2) if (m2 < own && m2 != n) rank += (gate[m2] > gate[n] || (gate[m2] == gate[n] && m2 < n)) ? 1 : 0;
            if (rank < 3) sel |= 1u << n;
        }
    }
    unsigned vis = 0;
#pragma unroll
    for (int n = 0; n < 7; ++n) if (n < own && __ballot((sel >> n) & 1u) != 0ull) vis |= 1u << n;
    LAS unsigned* wv = (LAS unsigned*)(lds + 131072 + 128);
    if (tid == 0) *wv = 0u;
    __syncthreads();
    if (c.lane == 0 && vis) __hip_atomic_fetch_or((unsigned*)wv, vis, __ATOMIC_RELAXED, __HIP_MEMORY_SCOPE_WORKGROUP);
    __syncthreads();
    const unsigned visw = *wv;
    const int nsteps = 2 * (__popc(visw) + 1);
    const int srow = tid >> 3, spc = tid & 7;
    u32x4 kr[2], vr[2];
#define BW_LOAD(blk_, half_) do { const int r0_ = 256 * (blk_) + 128 * (half_) + srow; \
        kr[0] = *(const u32x4*)(kbase + (size_t)r0_ * LDQ + spc * 8); kr[1] = *(const u32x4*)(kbase + (size_t)(r0_ + 64) * LDQ + spc * 8); \
        vr[0] = *(const u32x4*)(vbase + (size_t)r0_ * LDQ + spc * 8); vr[1] = *(const u32x4*)(vbase + (size_t)(r0_ + 64) * LDQ + spc * 8); } while (0)
#define BW_WRITE(buf_) do { LAS unsigned char* kb_ = lds + (buf_) * 2 * BST; LAS unsigned char* vb_ = kb_ + BST; \
        *(LAS u32x4*)(kb_ + srow * VROW + spc * 16) = kr[0]; *(LAS u32x4*)(kb_ + (srow + 64) * VROW + spc * 16) = kr[1]; \
        *(LAS u32x4*)(vb_ + srow * VROW + spc * 16) = vr[0]; *(LAS u32x4*)(vb_ + (srow + 64) * VROW + spc * 16) = vr[1]; } while (0)
    SoftState st; soft_init(st);
    unsigned rem = visw; int blk = rem ? (int)__builtin_ctz(rem) : own, half = 0;
    BW_LOAD(blk, 0); BW_WRITE(0);
    __syncthreads();
    for (int sidx = 0; sidx < nsteps; ++sidx) {
        int nblk = blk, nhalf = half ^ 1; unsigned nrem = rem;
        if (half == 1) { nrem = rem & (rem - 1u); nblk = nrem ? (int)__builtin_ctz(nrem) : own; }
        const bool has_next = (sidx + 1 < nsteps);
        if (has_next) BW_LOAD(nblk, nhalf);
        const LAS unsigned char* kst = lds + (sidx & 1) * 2 * BST; const LAS unsigned char* vst = kst + BST;
        if (blk == own) {
#pragma unroll 1
            for (int ch = 0; ch < 4; ++ch) { const int ci = 4 * half + ch;
                if (ci <= wid) soft_compute_lds(st, qf, kst + ch * 32 * VROW, vst + ch * 32 * VROW, 256 * blk + 32 * ci, qp, true, ci == wid, c); }
        } else if ((vis >> blk) & 1u) {
            const bool mine = ((sel >> blk) & 1u) != 0u;
#pragma unroll 1
            for (int ch = 0; ch < 4; ++ch) soft_compute_lds(st, qf, kst + ch * 32 * VROW, vst + ch * 32 * VROW, 256 * blk + 128 * half + 32 * ch, qp, mine, false, c);
        }
        if (has_next) BW_WRITE((sidx + 1) & 1);
        __syncthreads();
        blk = nblk; half = nhalf; rem = nrem;
    }
#undef BW_LOAD
#undef BW_WRITE
    store_o(st.o, __builtin_amdgcn_rcpf(st.l), outB + (size_t)(b * SEQ + qp) * 384 + hb * 64, c);
}
__device__ __forceinline__ void unit_C(const bf16_t* qkv, bf16_t* outC, int b, int hc, int qt, const WaveCtx& c) {
    const int qp = 32 * qt + c.q, head = 18 + hc;
    const bf16_t* rowb = qkv + (size_t)b * SEQ * LDQ;
    bf16x8 qf[4]; load_q(qf, rowb + (size_t)qp * LDQ + head * 64, c.h);
    const bf16_t* kbase = rowb + MIXW + head * 64; const bf16_t* vbase = rowb + 2 * MIXW + head * 64;
    f32x16 o[2];
#pragma unroll
    for (int r = 0; r < 16; ++r) { o[0][r] = 0.f; o[1][r] = 0.f; }
    float carry = 0.f;
    KV ta, tb;
    issue_kv<false>(ta, kbase, vbase, 32 * qt, 1, c);
    bool done = false;
#define C_STEP(T, ch) do { \
        const int k0 = 32 * (ch); \
        store_v(T.vr, c); VF vf; read_vf(vf, c); \
        f32x16 z = qk(T.kf, qf); \
        float lk[16], gs[4]; \
        const bool diag = ((ch) == qt); \
        _Pragma("unroll") for (int r = 0; r < 16; ++r) { \
            const bool ok = diag ? ((k0 + crow(r, c.h)) < qp) : true; \
            const float zz = z[r], sp = fmaxf(zz, 0.f) + __builtin_amdgcn_logf(1.0f + __builtin_amdgcn_exp2f(-fabsf(zz)));   \
            lk[r] = ok ? -sp : 0.f; \
            z[r] = ok ? (zz - sp) : -1e30f; } \
        _Pragma("unroll") for (int g4 = 0; g4 < 4; ++g4) gs[g4] = (lk[4 * g4] + lk[4 * g4 + 1]) + (lk[4 * g4 + 2] + lk[4 * g4 + 3]); \
        float os[4]; \
        _Pragma("unroll") for (int g4 = 0; g4 < 4; ++g4) os[g4] = xor32_get(gs[g4], c.h); \
        float T_ = 0.f; \
        _Pragma("unroll") for (int g4 = 3; g4 >= 0; --g4) { \
            const float base = carry + T_ + (c.h == 0 ? os[g4] : 0.f); \
            const float a3 = base, a2 = a3 + lk[4 * g4 + 3], a1 = a2 + lk[4 * g4 + 2], a0 = a1 + lk[4 * g4 + 1]; \
            z[4 * g4 + 3] = __builtin_amdgcn_exp2f(z[4 * g4 + 3] + a3); z[4 * g4 + 2] = __builtin_amdgcn_exp2f(z[4 * g4 + 2] + a2); \
            z[4 * g4 + 1] = __builtin_amdgcn_exp2f(z[4 * g4 + 1] + a1); z[4 * g4 + 0] = __builtin_amdgcn_exp2f(z[4 * g4 + 0] + a0); \
            T_ += gs[g4] + os[g4]; } \
        carry += T_; \
        pv(o, z, vf); \
        done = (__ballot(carry > -150.5f) == 0ull);   } while (0)
    for (int ch = qt; ch >= 0; ch -= 2) {
        if (ch > 0) issue_kv<false>(tb, kbase, vbase, 32 * (ch - 1), 1, c);
        C_STEP(ta, ch);
        if (done || ch == 0) break;
        if (ch > 1) issue_kv<false>(ta, kbase, vbase, 32 * (ch - 2), 1, c);
        C_STEP(tb, ch - 1);
        if (done) break;
    }
#undef C_STEP
    store_o(o, 1.0f, outC + (size_t)(b * SEQ + qp) * 384 + hc * 64, c);
}

__device__ __forceinline__ void attn_phase(const Params& p, unsigned char* ws, int layer, LAS unsigned char* lds, const int tid, int rep) {
    const int wid = __builtin_amdgcn_readfirstlane(tid >> 6);
    const bf16_t* qkv = (const bf16_t*)(ws + WS_QKV);
    const float* kmean = (const float*)(ws + WS_KMEAN);
    bf16_t* outA = (bf16_t*)(ws + WS_ATTA); bf16_t* outB = (bf16_t*)(ws + WS_ATTB); bf16_t* outC = (bf16_t*)(ws + WS_ATTC);
    if (wid >= 4) __builtin_amdgcn_s_setprio(1);
    const bool a_static = (gridDim.x == 256);
    if (a_static) {
        int t2 = tid; asm volatile("" : "+v"(t2));
        const int lane = t2 & 63;
        WaveCtx c; c.lane = lane; c.q = lane & 31; c.h = lane >> 5; c.vl = lds + wid * VTILE;
        { const int i = lane & 15, qq = i >> 2, pp = i & 3, blk = (lane >> 4) & 1; c.troff = (4 * c.h + qq) * VROW + (16 * blk + 4 * pp) * 2; }
        const int g8 = (int)blockIdx.x, jb = g8 >> 3;
        unit_A2(qkv, outA, g8 & 7, jb >> 3, jb & 7, wid, lds, c);
        __syncthreads();
    }
    for (int rb = 0; rb < REP_B; ++rb) {
        unsigned* ctrB = (unsigned*)(ws + WS_CTR) + 4096 + (layer * 2 + rb) * 64;
        LAS unsigned* qw = (LAS unsigned*)(lds + 131072 + 192);
        for (;;) {
            int t2 = tid; asm volatile("" : "+v"(t2));
            const int lane = t2 & 63;
            WaveCtx c; c.lane = lane; c.q = lane & 31; c.h = lane >> 5; c.vl = lds;
            { const int i = lane & 15, qq = i >> 2, pp = i & 3, blk = (lane >> 4) & 1; c.troff = (4 * c.h + qq) * VROW + (16 * blk + 4 * pp) * 2; }
            __syncthreads();
            if (t2 == 0) *qw = atomicAdd(ctrB, 1u);
            __syncthreads();
            const unsigned u = (unsigned)__builtin_amdgcn_readfirstlane((int)*qw);
            const unsigned ngu = (gridDim.x == 256) ? 128u : 0u;
            if (u >= 384u + ngu) break;
            if (u >= 192u && u < 192u + ngu) {
                pg8::StaticOrder so; so.init(M, NQKVG, 256, (int)(u - 192u));
                OneUnit S1; so.next(7, S1.u0);
                pg8::Gemm g{(const bf16_t*)(ws + WS_H), (const bf16_t*)(ws + WS_W + W_QKVG), M, NQKVG, DM};
                EpiQKVG E{(bf16_t*)(ws + WS_QKV), (bf16_t*)(ws + WS_GATES), p.b_gate + (size_t)layer * NG, (const float*)(ws + WS_COS), (const float*)(ws + WS_SIN), (float*)(ws + WS_KMEAN)};
                pg8::gemm_phase<EpiQKVG, OneUnit, false, GSP2>(lds, g, S1, E, t2);
                if (wid >= 4) __builtin_amdgcn_s_setprio(1);
                continue;
            }
            const unsigned ub = (u < 192u) ? u : u - ngu;
            const int qb = 7 - (int)(ub / 48u), r2 = (int)(ub % 48u);
            wg_unit_B(qkv, kmean, outB, r2 / 6, r2 % 6, qb, lds, wid, c, t2);
        }
        __syncthreads();
    }
    const int qid = blockIdx.x & 7;
    for (int rac = 0; rac < REP_AC; ++rac) {
    unsigned* ctr = (unsigned*)(ws + WS_CTR) + ((layer * 8 + qid) * 2 + rac) * 64;
    for (;;) {
        int t2 = tid; asm volatile("" : "+v"(t2));
        const int lane = t2 & 63;
        WaveCtx c; c.lane = lane; c.q = lane & 31; c.h = lane >> 5; c.vl = lds + wid * VTILE;
        { const int i = lane & 15, qq = i >> 2, pp = i & 3, blk = (lane >> 4) & 1; c.troff = (4 * c.h + qq) * VROW + (16 * blk + 4 * pp) * 2; }
        unsigned u = 0;
        if (lane == 0) u = atomicAdd(ctr, 1u);
        u = (unsigned)__builtin_amdgcn_readfirstlane((int)u);
        if (a_static) u += 256u;
        if (u >= 640u) break;
        const int wgu = (int)(u >> 3) * 8 + qid, sub = (int)(u & 7);
        if (wgu < 256) { unit_A(qkv, outA, wgu >> 5, (wgu & 31) >> 3, wgu & 7, sub, c); }
        else { const int w2 = wgu - 256, qb = 7 - w2 / 48, r2 = w2 % 48; unit_C(qkv, outC, r2 / 6, r2 % 6, qb * 8 + sub, c); }
    }
    }
    __builtin_amdgcn_s_setprio(0);
}

__device__ __forceinline__ void mod_gemv(const Params& p, LAS unsigned char* lds, const int tid, const int l, const int u0, const int ustride) {
    LAS float* cact = (LAS float*)lds;
    for (int i = tid; i < NB * DM; i += NTHR) { const float v = p.c[i]; cact[i] = v / (1.0f + __expf(-v)); }
    __syncthreads();
    float* mod = (float*)(p.ws + WS_MOD);
    LAS float* red2 = (LAS float*)(lds + 32768);
    const int hw = tid >> 5, cl = tid & 31;
    for (int unit = u0; unit < 192; unit += ustride) {
        const int n0 = unit * 32;
        const float* W = p.w_ada + (size_t)l * DM * 6 * DM + (size_t)(hw * 64) * 6 * DM + n0 + cl;
        float a[8];
#pragma unroll
        for (int b = 0; b < 8; ++b) a[b] = 0.f;
#pragma unroll 1
        for (int kb = 0; kb < 64; kb += 16) {
            float w[16];
#pragma unroll
            for (int j = 0; j < 16; ++j) w[j] = W[(size_t)(kb + j) * 6 * DM];
#pragma unroll
            for (int j = 0; j < 16; ++j)
#pragma unroll
                for (int b = 0; b < 8; ++b) a[b] += cact[b * DM + hw * 64 + kb + j] * w[j];
        }
#pragma unroll
        for (int b = 0; b < 8; ++b) red2[(hw * 8 + b) * 32 + cl] = a[b];
        __syncthreads();
        if (tid < 256) {
            const int b = tid >> 5; float sum = 0.f;
#pragma unroll
            for (int h2 = 0; h2 < 16; ++h2) sum += red2[(h2 * 8 + b) * 32 + cl];
            mod[((size_t)l * NB + b) * 6 * DM + n0 + cl] = sum + p.b_ada[(size_t)l * 6 * DM + n0 + cl];
        }
        __syncthreads();
    }
}
__device__ __forceinline__ void phase0(const Params& p, LAS unsigned char* lds, const int tid) {
    if (blockIdx.x == 0) { for (int i = tid; i < 4096 + DEPTH * 2 * 64; i += NTHR) ((unsigned*)(p.ws + WS_CTR))[i] = 0u; }
    {
        float* cosT = (float*)(p.ws + WS_COS); float* sinT = (float*)(p.ws + WS_SIN);
        for (int i = blockIdx.x * NTHR + tid; i < SEQ * 32; i += gridDim.x * NTHR) {
            const int pos = i >> 5, j = i & 31;
            const float inv = exp2f(-(float)j * 0.41524101186092029f);
            const float ang = (float)pos * inv;
            double a = (double)ang; const double twopi = 6.283185307179586476925;
            a -= twopi * rint(a / twopi);
            const double a2 = a * a;
            double cs = 1.0, term = 1.0, sn = a, ts = a;
#pragma unroll 1
            for (int k = 1; k <= 14; ++k) { term *= -a2 / (double)((2 * k - 1) * (2 * k)); cs += term; ts *= -a2 / (double)((2 * k) * (2 * k + 1)); sn += ts; }
            cosT[i] = (float)cs; sinT[i] = (float)sn;
        }
    }
    for (int i = blockIdx.x * NTHR + tid; i < 8 * 64 * 64; i += 256 * NTHR) { if (blockIdx.x < 256) ((unsigned*)(p.ws + WS_CNT))[i] = 0u; }
    for (int i = blockIdx.x * NTHR + tid; i < M * 16; i += 256 * NTHR) { if (blockIdx.x < 256) *(u32x4*)((bf16_t*)(p.ws + WS_ATTA) + (size_t)(i >> 4) * 384 + 256 + (i & 15) * 8) = (u32x4){0u, 0u, 0u, 0u}; }
    const int nl = (gridDim.x == 256) ? 1 : DEPTH;
    for (int l = 0; l < nl; ++l) mod_gemv(p, lds, tid, l, (int)blockIdx.x, (int)gridDim.x);
}
__device__ __forceinline__ void norm_rows(const float* x, const float* g, const float* modl  , int sh_off, int sc_off, bf16_t* h, int gw, int ngw, int lane) {
    f32x4 gv[4];
#pragma unroll
    for (int j = 0; j < 4; ++j) gv[j] = *((const f32x4*)g + lane + 64 * j);
    for (int row = gw; row < M; row += ngw) {
        const f32x4* xr = (const f32x4*)(x + (size_t)row * DM) + lane;
        f32x4 v[4]; float ss = 0.f;
#pragma unroll
        for (int j = 0; j < 4; ++j) { v[j] = xr[64 * j]; ss += (v[j].x * v[j].x + v[j].y * v[j].y) + (v[j].z * v[j].z + v[j].w * v[j].w); }
        const float rstd = 1.0f / sqrtf(wave_sum(ss) * (1.0f / DM) + NORM_EPS);
        const float* mb = modl + (size_t)(row >> 11) * 6 * DM;
        unsigned long long* o8 = (unsigned long long*)(h + (size_t)row * DM) + lane;
#pragma unroll
        for (int j = 0; j < 4; ++j) {
            const f32x4 sc = *((const f32x4*)(mb + sc_off) + lane + 64 * j), sh = *((const f32x4*)(mb + sh_off) + lane + 64 * j);
            const f32x4 y = v[j] * rstd * gv[j] * (sc + 1.0f) + sh;
            o8[64 * j] = (unsigned long long)pk2(y.x, y.y) | ((unsigned long long)pk2(y.z, y.w) << 32);
        }
    }
}
__device__ __forceinline__ void final_norm(float* x, const float* g, int gw, int ngw, int lane) {
    f32x4 gv[4];
#pragma unroll
    for (int j = 0; j < 4; ++j) gv[j] = *((const f32x4*)g + lane + 64 * j);
    for (int row = gw; row < M; row += ngw) {
        f32x4* xr = (f32x4*)(x + (size_t)row * DM) + lane;
        f32x4 v[4]; float ss = 0.f;
#pragma unroll
        for (int j = 0; j < 4; ++j) { v[j] = xr[64 * j]; ss += (v[j].x * v[j].x + v[j].y * v[j].y) + (v[j].z * v[j].z + v[j].w * v[j].w); }
        const float rstd = 1.0f / sqrtf(wave_sum(ss) * (1.0f / DM) + NORM_EPS);
#pragma unroll
        for (int j = 0; j < 4; ++j) xr[64 * j] = v[j] * rstd * gv[j];
    }
}
__device__ __forceinline__ void convert_weights(const Params& p, unsigned char* ws, int l, LAS unsigned char* lds, int gw, int ngw, int wid, int lane) {
    LAS float* scr = (LAS float*)(lds + wid * 16384);
    unsigned char* wb = ws + WS_W;
    constexpr int I_IN = 16 * 144, I_G = 16 * 96, I_A = 4 * 32, I_B = 6 * 32, I_O = 16 * 32, I_GU = 16 * 176, I_D = 44 * 32;
    constexpr int NIT = I_IN + I_G + I_A + 2 * I_B + I_O + I_GU + I_D;
    for (int it = gw; it < NIT; it += ngw) {
        int r = it;
        if (r < I_IN) { transpose_item(p.w_in + (size_t)l * DM * LDQ, DM, LDQ, (bf16_t*)(wb + W_QKVG), DM, 0, 1, scr, r, lane); continue; } r -= I_IN;
        if (r < I_G) { transpose_item(p.w_gate + (size_t)l * DM * NG, DM, NG, (bf16_t*)(wb + W_QKVG), DM, LDQ, 0, scr, r, lane); continue; } r -= I_G;
        if (r < I_A) { transpose_item(p.w_br_a + (size_t)l * 256 * DM, 256, DM, (bf16_t*)(wb + W_A), 384, 0, 0, scr, r, lane); continue; } r -= I_A;
        if (r < I_B) { transpose_item(p.w_br_b + (size_t)l * 384 * DM, 384, DM, (bf16_t*)(wb + W_B), 384, 0, 0, scr, r, lane); continue; } r -= I_B;
        if (r < I_B) { transpose_item(p.w_br_c + (size_t)l * 384 * DM, 384, DM, (bf16_t*)(wb + W_C), 384, 0, 0, scr, r, lane); continue; } r -= I_B;
        if (r < I_O) { transpose_item(p.w_out + (size_t)l * DM * DM, DM, DM, (bf16_t*)(wb + W_O), DM, 0, 0, scr, r, lane); continue; } r -= I_O;
        if (r < I_GU) { transpose_item(p.w_gu + (size_t)l * DM * NGU, DM, NGU, (bf16_t*)(wb + W_GU), DM, 0, 2, scr, r, lane); continue; } r -= I_GU;
        transpose_item(p.w_down + (size_t)l * DFF * DM, DFF, DM, (bf16_t*)(wb + W_D), DFF, 0, 0, scr, r, lane);
    }
    { unsigned z = 0u; asm volatile("" : "+v"(z));
      for (int r = gw; r < DM; r += ngw) { if (lane < 16) *(u32x4*)((bf16_t*)(wb + W_A) + (size_t)r * 384 + 256 + lane * 8) = (u32x4){z, z, z, z}; } }
}

constexpr int PPL = 7;
constexpr int N_PHASES = 1 + PPL * DEPTH;
__global__ void __launch_bounds__(NTHR, 2) fwd_kernel(Params p) {
    extern __shared__ __attribute__((aligned(16))) unsigned char lds_raw[];
    LAS unsigned char* lds = (LAS unsigned char*)lds_raw;
    const int G = gridDim.x, ngw = G * NWAVES;
    volatile LAS unsigned* bst = (volatile LAS unsigned*)(lds + 131072 + 64);
    if (threadIdx.x < 2) bst[threadIdx.x] = 0u;
    __syncthreads();
    (void)xcd_barrier_post((unsigned*)(p.ws + WS_BAR), bst);
    if (p.ph_lo == 0) {
        int tid = threadIdx.x; asm volatile("" : "+v"(tid));
        for (int rep = 0; rep < REP_P0; ++rep) { phase0(p, lds, tid); __syncthreads(); }
        if (p.ph_hi > 1) xcd_barrier((unsigned*)(p.ws + WS_BAR), (volatile LAS unsigned*)(lds + 131072 + 64), tid);
        if (p.ph_hi < 0) cg::this_grid().sync();
    }
    const int ph_a = p.ph_lo < 1 ? 1 : p.ph_lo, ph_b = p.ph_hi;
    const int wid_s = __builtin_amdgcn_readfirstlane((int)(threadIdx.x >> 6));
    for (int ph = ph_a; ph < ph_b; ++ph) {
        unsigned ones = ~0u; asm volatile("" : "+s"(ones));
        int tid = wid_s * 64 + (int)__builtin_amdgcn_mbcnt_hi(ones, __builtin_amdgcn_mbcnt_lo(ones, 0u)); asm volatile("" : "+v"(tid));
        unsigned char* ws = p.ws; asm volatile("" : "+s"(ws));
        float* mod = (float*)(ws + WS_MOD);
        bf16_t* H = (bf16_t*)(ws + WS_H); bf16_t* QKV = (bf16_t*)(ws + WS_QKV); bf16_t* GATES = (bf16_t*)(ws + WS_GATES);
        bf16_t* MERGED = (bf16_t*)(ws + WS_MERGED); bf16_t* ACT = (bf16_t*)(ws + WS_QKV);
        unsigned char* wb = ws + WS_W;
        {
            const int l = (ph - 1) / PPL, k = (ph - 1) % PPL;
            const float* modl = mod + (size_t)l * NB * 6 * DM;
            const float* xin = (l == 0) ? p.x : p.out;
            switch (k) {
#if PHEN(0)
            case 0: {
                float* km = (float*)(ws + WS_KMEAN);
                if (blockIdx.x == 0) { for (int i = tid; i < NB * 6 * 8 * 64; i += NTHR) km[i] = 0.f; }
                const int lane = tid & 63, wid = __builtin_amdgcn_readfirstlane(tid >> 6), gw = blockIdx.x * NWAVES + wid;
                convert_weights(p, ws, l, lds, gw, ngw, wid, lane);
                if (l == 0) norm_rows(p.x, p.norm1_g, modl, 0, DM, H, gw, ngw, lane);
            } break;
#endif
#if PHEN(1)
            case 1: {
                pg8::Gemm g{H, (const bf16_t*)(wb + W_QKVG), M, NQKVG, DM}; LimitOrder S; S.base.init(M, NQKVG, G, (int)blockIdx.x); S.lim = (G == 256) ? 7 : 1000;
                EpiQKVG E{QKV, GATES, p.b_gate + (size_t)l * NG, (const float*)(ws + WS_COS), (const float*)(ws + WS_SIN), (float*)(ws + WS_KMEAN)};
                pg8::gemm_phase<EpiQKVG, LimitOrder, GALIGN, GSP2>(lds, g, S, E, tid);
            } break;
#endif
#if PHEN(2)
            case 2: for (int rep = 0; rep < REP_ATT; ++rep) { attn_phase(p, ws, l, lds, tid, rep); __syncthreads(); } break;
#endif
#if PHEN(3)
            case 3: {
                pg8::Gemm g{(const bf16_t*)(ws + WS_ATTA), (const bf16_t*)(wb + W_A), 3 * M, 3 * DM, 384};
                BranchOrder S; S.base.init(M, DM, G, (int)blockIdx.x);
                EpiBranch E{GATES, MERGED};
                pg8::gemm_phase<EpiBranch, BranchOrder, GALIGN, GSP2>(lds, g, S, E, tid);
            } break;
#endif
#if PHEN(4)
            case 4: {
                pg8::Gemm g{MERGED, (const bf16_t*)(wb + W_O), M, DM, DM}; pg8::StaticOrder S; S.init(M, DM, G, (int)blockIdx.x);
                RowStats rs{(unsigned*)(ws + WS_XBUF), (unsigned*)(ws + WS_CNT) + (size_t)(2 * l) * 64 * 64};
                EpiResidNorm E{l == 0 ? p.x : nullptr, (const bf16_t*)(ws + WS_X16), (bf16_t*)(ws + WS_GATES), nullptr, modl + 2 * DM, H, p.norm2_g + (size_t)l * DM, modl + 4 * DM, modl + 3 * DM, rs, 0};
                pg8::gemm_phase<EpiResidNorm, pg8::StaticOrder, false, GSP2>(lds, g, S, E, tid);
            } break;
#endif
#if PHEN(6)
            case 5: {
                pg8::Gemm g{H, (const bf16_t*)(wb + W_GU), M, NGU, DM}; pg8::StaticOrder S; S.init(M, NGU, G, (int)blockIdx.x);
                EpiSwiGLU E{ACT};
                pg8::gemm_phase<EpiSwiGLU, pg8::StaticOrder, GALIGN, GSP2>(lds, g, S, E, tid);
                if (G == 256 && l + 1 < DEPTH) {
                    const int full = ((M / 256) * (NGU / 256)) % G;
                    if ((int)blockIdx.x >= full) { __syncthreads(); mod_gemv(p, lds, tid, l + 1, (int)blockIdx.x - full, G - full); }
                }
            } break;
#endif
#if PHEN(7)
            case 6: {
                pg8::Gemm g{ACT, (const bf16_t*)(wb + W_D), M, DM, DFF}; pg8::StaticOrder S; S.init(M, DM, G, (int)blockIdx.x);
                RowStats rs{(unsigned*)(ws + WS_XBUF), (unsigned*)(ws + WS_CNT) + (size_t)(2 * l + 1) * 64 * 64};
                const bool fin = (l == DEPTH - 1);
                const float* modn = mod + (size_t)(fin ? l : l + 1) * NB * 6 * DM;
                EpiResidNorm E{nullptr, (const bf16_t*)(ws + WS_GATES), (bf16_t*)(ws + WS_X16), p.out, modl + 5 * DM, H, fin ? p.final_g : p.norm1_g + (size_t)(l + 1) * DM, modn + DM, modn, rs, fin ? 1 : 0};
                pg8::gemm_phase<EpiResidNorm, pg8::StaticOrder, false, GSP2>(lds, g, S, E, tid);
            } break;
#endif
            default: break;
            }
        }
        if (ph + 1 < p.ph_hi) { for (int rep = 0; rep < REP_SYNC; ++rep) xcd_barrier((unsigned*)(ws + WS_BAR), (volatile LAS unsigned*)(lds + 131072 + 64), tid); }
    }
}

extern "C" void kernel_launch(void* const* d_in, const int* in_sizes, int n_in, void* d_out, int out_size, void* d_ws, size_t ws_size, hipStream_t stream) {
    static int grid = 0;
    if (grid == 0) {
        if (n_in != 16 || out_size != M * DM || ws_size < WS_END) { fprintf(stderr, "kernel_launch: unexpected sizes n_in %d out %d ws %zu\n", n_in, out_size, ws_size); grid = -1; return; }
        int dev = 0, cus = 0, per_cu = 0;
        if (hipGetDevice(&dev) != hipSuccess || hipDeviceGetAttribute(&cus, hipDeviceAttributeMultiprocessorCount, dev) != hipSuccess) { grid = -1; return; }
        if (hipFuncSetAttribute((const void*)fwd_kernel, hipFuncAttributeMaxDynamicSharedMemorySize, LDS_BYTES) != hipSuccess) { fprintf(stderr, "kernel_launch: hipFuncSetAttribute failed\n"); grid = -1; return; }
        if (hipOccupancyMaxActiveBlocksPerMultiprocessor(&per_cu, (const void*)fwd_kernel, NTHR, LDS_BYTES) != hipSuccess || per_cu < 1) { fprintf(stderr, "kernel_launch: occupancy query says %d\n", per_cu); per_cu = 1; }
        (void)hipGetLastError();
        grid = cus * 1;
    }
    if (grid < 0) return;
    if (hipMemsetAsync((char*)d_ws + WS_BAR, 0, XCD_BAR_WORDS * 4, stream) != hipSuccess) { fprintf(stderr, "kernel_launch: memset failed\n"); return; }
    Params p{};
    p.x = (const float*)d_in[0]; p.c = (const float*)d_in[1]; p.w_ada = (const float*)d_in[2]; p.b_ada = (const float*)d_in[3]; p.norm1_g = (const float*)d_in[4];
    p.w_in = (const float*)d_in[5]; p.w_br_a = (const float*)d_in[6]; p.w_br_b = (const float*)d_in[7]; p.w_br_c = (const float*)d_in[8]; p.w_gate = (const float*)d_in[9];
    p.b_gate = (const float*)d_in[10]; p.w_out = (const float*)d_in[11]; p.norm2_g = (const float*)d_in[12]; p.w_gu = (const float*)d_in[13]; p.w_down = (const float*)d_in[14];
    p.final_g = (const float*)d_in[15];
    p.out = (float*)d_out; p.ws = (unsigned char*)d_ws;
#if MK_MULTI_LAUNCH
    for (int ph = 0; ph < N_PHASES; ++ph) {
        p.ph_lo = ph; p.ph_hi = ph + 1;
        hipLaunchKernelGGL(fwd_kernel, dim3(grid), dim3(NTHR), LDS_BYTES, stream, p);
    }
#else
    p.ph_lo = 0; p.ph_hi = N_PHASES;
    void* args[] = {&p};
    hipError_t e = hipLaunchCooperativeKernel((const void*)fwd_kernel, dim3(grid), dim3(NTHR), args, LDS_BYTES, stream);
    if (e != hipSuccess) fprintf(stderr, "cooperative launch failed: %s (grid %d)\n", hipGetErrorString(e), grid);
#endif
}
```

```cpp
#include <hip/hip_runtime.h>
#include <hip/hip_cooperative_groups.h>
#include <cstdio>
#include <cstdint>
namespace cg = cooperative_groups;

#ifndef PHMASK
#define PHMASK 0xff
#endif
#define PHEN(k) ((PHMASK >> (k)) & 1)
#ifndef REPK
#define REPK -1
#endif
#ifndef REP_P0
#define REP_P0 1
#endif
#ifndef REP_B
#define REP_B 1
#endif
#ifndef REP_AC
#define REP_AC 1
#endif
#ifndef REP_ATT
#define REP_ATT 1
#endif
#ifndef REP_GU
#define REP_GU 1
#endif
#ifndef REP_SYNC
#define REP_SYNC 1
#endif
#ifndef REP_NORM
#define REP_NORM 1
#endif
#ifndef GALIGN
#define GALIGN true
#endif
#ifndef GSP2
#define GSP2 true
#endif
#ifndef MK_MULTI_LAUNCH
#define MK_MULTI_LAUNCH 0
#endif

namespace pg8 {
#define PG8_LAS __attribute__((address_space(3)))
typedef unsigned short bf16_t;
typedef short bf16x8 __attribute__((ext_vector_type(8)));
typedef float f32x4 __attribute__((ext_vector_type(4)));
typedef unsigned u32x4 __attribute__((ext_vector_type(4)));
constexpr int BM = 256, BK = 64, HALF = 128, HTB = HALF * BK * 2  , STAGE_BYTES = 8 * HTB, NXCD = 8, WGM = 8;

__host__ __device__ __forceinline__ int lds_byte(int r, int c) { const int st = (r >> 4) * 2 + (c >> 5), rr = r & 15, cc = c & 31, ob = rr * 64 + cc * 2; return st * 1024 + (ob ^ (((ob >> 9) & 1) << 5)); }
__host__ __device__ __forceinline__ void stage_rc(int b, int& R, int& C) { const int st = b / 1024, sb = b % 1024, swz = sb ^ (((sb >> 9) & 1) << 5); R = (st >> 1) * 16 + swz / 64; C = (st & 1) * 32 + (swz % 64) / 2; }
__host__ __device__ __forceinline__ int perm32(int rho) { const int n = rho >> 4, i = rho & 15; return 8 * (i >> 2) + 4 * n + (i & 3); }

struct Unit { int pm, pn; };
struct Gemm { const bf16_t* A; const bf16_t* Bt; int M, N, K; };

struct StaticOrder {
    int nM, nN, nwg, G, c;
    __host__ __device__ void init(int M, int N, int G_, int c_) { nM = M / BM; nN = N / BM; nwg = nM * nN; G = G_; c = c_; }
    __host__ __device__ bool next(int i, Unit& u) const {
        const long L = (long)i * G + c; if (L >= nwg) return false;
        int wgid = (int)L; { const int q = nwg / NXCD, r = nwg % NXCD, xcd = wgid % NXCD, off = wgid / NXCD; wgid = (xcd < r ? xcd * (q + 1) : r * (q + 1) + (xcd - r) * q) + off; }
        const int nig = WGM * nN, gid = wgid / nig, fm = gid * WGM, gsz = (nM - fm) < WGM ? (nM - fm) : WGM;
        u.pm = fm + ((wgid % nig) % gsz); u.pn = (wgid % nig) / gsz; return true;
    }
    __device__ __forceinline__ void a_ready(const Unit&) const {}
    __device__ __forceinline__ void done(const Unit&) const {}
};

__device__ __forceinline__ unsigned cvt_pk_bf16(float lo, float hi) { unsigned r; asm volatile("v_cvt_pk_bf16_f32 %0, %1, %2" : "=v"(r) : "v"(lo), "v"(hi)); return r; }

template <class Epi, class Sched, bool ALIGN_EPI = false, bool SP2 = false>
__device__ __forceinline__ void gemm_phase(PG8_LAS unsigned char* lds, const Gemm g, const Sched& S, const Epi& E, const int tid) {
    const int wid = __builtin_amdgcn_readfirstlane(tid >> 6), lane = tid & 63, wr = wid >> 2, wc = wid & 3, fr = lane & 15, fq = lane >> 4;
    const int K = g.K, nt = K / BK;
    unsigned voffA[2], voffB[2];
#pragma unroll
    for (int i = 0; i < 2; ++i) { int R, C; stage_rc(tid * 16 + i * 8192, R, C); const int Rb = Epi::PERM ? ((R & ~31) + perm32(R & 31)) : R;
        voffA[i] = (unsigned)(R * K + C) * 2u; voffB[i] = (unsigned)(Rb * K + C) * 2u; }
    const size_t kstep = (size_t)(BK * 2);
    const size_t hstep = (size_t)HALF * K * 2;
    const size_t tstep = 2 * hstep;
    const unsigned ldsw = (unsigned)wid * 1024u;
    const int aoff = lds_byte(wr * 64 + fr, fq * 8), boff = lds_byte(wc * 32 + fr, fq * 8);
#define PG8_SA(b, h) (((b) * 2 + (h)) * HTB)
#define PG8_SB(b, h) ((4 + (b) * 2 + (h)) * HTB)
#define PG8_STAGE(bufoff, gbase, voff) do { _Pragma("unroll") for (int _i = 0; _i < 2; ++_i) \
        __builtin_amdgcn_global_load_lds((const unsigned*)((const char*)(gbase) + (voff)[_i]), (PG8_LAS unsigned*)(lds + (bufoff) + ldsw + _i * 8192), 16, 0, 0); } while (0)
#define PG8_LDA(dst, b, h) do { _Pragma("unroll") for (int m = 0; m < 4; ++m) _Pragma("unroll") for (int k = 0; k < 2; ++k) dst[m][k] = *(const PG8_LAS bf16x8*)(lds + PG8_SA(b, h) + aoff + m * 2048 + k * 1024); } while (0)
#define PG8_LDB(dst, b, h) do { _Pragma("unroll") for (int n = 0; n < 2; ++n) _Pragma("unroll") for (int k = 0; k < 2; ++k) dst[n][k] = *(const PG8_LAS bf16x8*)(lds + PG8_SB(b, h) + boff + n * 2048 + k * 1024); } while (0)
#define PG8_MMA(ai, bj, At, Bt) do { __builtin_amdgcn_s_setprio(1); _Pragma("unroll") for (int m = 0; m < 4; ++m) _Pragma("unroll") for (int n = 0; n < 2; ++n) _Pragma("unroll") for (int k = 0; k < 2; ++k) \
        acc[ai][bj][m][n] = __builtin_amdgcn_mfma_f32_16x16x32_bf16(Bt[n][k], At[m][k], acc[ai][bj][m][n], 0, 0, 0); __builtin_amdgcn_s_setprio(0); } while (0)
#define PG8_WAIT_V(n) asm volatile("s_waitcnt vmcnt(" #n ")" ::: "memory")
#define PG8_WAIT_L(n) asm volatile("s_waitcnt lgkmcnt(" #n ")" ::: "memory")
#define PG8_BAR __builtin_amdgcn_s_barrier()
#define PG8_SCHED __builtin_amdgcn_sched_barrier(0)
    Unit cur, nxt; int ui = 0;
    if (!S.next(0, cur)) return;
    f32x4 acc[2][2][4][2];
#pragma unroll
    for (int a = 0; a < 2; ++a)
#pragma unroll
        for (int b = 0; b < 2; ++b)
#pragma unroll
            for (int m = 0; m < 4; ++m)
#pragma unroll
                for (int n = 0; n < 2; ++n) acc[a][b][m][n] = (f32x4){0.f, 0.f, 0.f, 0.f};
    bf16x8 At[4][2], B0[2][2], B1[2][2];
    const char* cA = (const char*)g.A + (size_t)cur.pm * tstep; const char* cB = (const char*)g.Bt + (size_t)cur.pn * tstep;
    S.a_ready(cur);
    if constexpr (SP2) {
        PG8_STAGE(PG8_SB(0, 0), cB, voffB); PG8_STAGE(PG8_SB(0, 1), cB + hstep, voffB); PG8_STAGE(PG8_SA(0, 0), cA, voffA); PG8_STAGE(PG8_SA(0, 1), cA + hstep, voffA);
        if (wr == 1) PG8_BAR;
        PG8_WAIT_V(2); PG8_BAR;
        PG8_STAGE(PG8_SB(1, 0), cB + kstep, voffB); PG8_STAGE(PG8_SA(1, 0), cA + kstep, voffA); PG8_STAGE(PG8_SB(1, 1), cB + hstep + kstep, voffB);
        PG8_WAIT_V(6); PG8_BAR;
    } else {
        PG8_STAGE(PG8_SB(0, 0), cB, voffB); PG8_STAGE(PG8_SA(0, 0), cA, voffA); PG8_STAGE(PG8_SB(0, 1), cB + hstep, voffB); PG8_STAGE(PG8_SA(0, 1), cA + hstep, voffA);
        if (wr == 1) PG8_BAR;
        PG8_WAIT_V(4); PG8_BAR;
        PG8_STAGE(PG8_SB(1, 0), cB + kstep, voffB); PG8_STAGE(PG8_SA(1, 0), cA + kstep, voffA); PG8_STAGE(PG8_SB(1, 1), cB + hstep + kstep, voffB);
        PG8_WAIT_V(6); PG8_BAR;
    }
    for (;;) {
        const bool has_next = S.next(ui + 1, nxt);
        const char* nA = has_next ? (const char*)g.A + (size_t)nxt.pm * tstep : cA; const char* nB = has_next ? (const char*)g.Bt + (size_t)nxt.pn * tstep : cB;
        for (int t = 0; t < nt; t += 2) {
            const bool last = (t == nt - 2);
            const char* a1 = cA + (size_t)(t + 1) * kstep;
            const char* a2 = last ? nA : cA + (size_t)(t + 2) * kstep; const char* b2 = last ? nB : cB + (size_t)(t + 2) * kstep;
            const char* a3 = a2 + kstep; const char* b3 = b2 + kstep;
            if (last && has_next) S.a_ready(nxt);
            if constexpr (SP2) {
            PG8_LDB(B0, 0, 0); PG8_LDB(B1, 0, 1); PG8_SCHED; PG8_LDA(At, 0, 0); PG8_STAGE(PG8_SA(1, 1), a1 + hstep, voffA);
            PG8_WAIT_V(8); PG8_WAIT_L(0); PG8_BAR; PG8_MMA(0, 0, At, B0); PG8_MMA(0, 1, At, B1); PG8_BAR; PG8_SCHED;
            PG8_LDA(At, 0, 1); PG8_STAGE(PG8_SB(0, 0), b2, voffB); PG8_STAGE(PG8_SB(0, 1), b2 + hstep, voffB); PG8_STAGE(PG8_SA(0, 0), a2, voffA);
            PG8_WAIT_V(8); PG8_WAIT_L(0); PG8_BAR; PG8_MMA(1, 0, At, B0); PG8_MMA(1, 1, At, B1); PG8_BAR; PG8_SCHED;
            PG8_LDB(B0, 1, 0); PG8_LDB(B1, 1, 1); PG8_SCHED; PG8_LDA(At, 1, 0); PG8_STAGE(PG8_SA(0, 1), a2 + hstep, voffA);
            PG8_WAIT_V(8); PG8_WAIT_L(0); PG8_BAR; PG8_MMA(0, 0, At, B0); PG8_MMA(0, 1, At, B1); PG8_BAR; PG8_SCHED;
            PG8_LDA(At, 1, 1); PG8_STAGE(PG8_SB(1, 0), b3, voffB); PG8_STAGE(PG8_SB(1, 1), b3 + hstep, voffB); PG8_STAGE(PG8_SA(1, 0), a3, voffA);
            PG8_WAIT_V(8); PG8_WAIT_L(0); PG8_BAR; PG8_MMA(1, 0, At, B0); PG8_MMA(1, 1, At, B1); PG8_BAR; PG8_SCHED;
            } else {
            PG8_LDB(B0, 0, 0); PG8_SCHED; PG8_LDA(At, 0, 0); PG8_STAGE(PG8_SA(1, 1), a1 + hstep, voffA);
            PG8_WAIT_L(8); PG8_BAR; PG8_WAIT_L(0); PG8_MMA(0, 0, At, B0); PG8_BAR; PG8_SCHED;
            PG8_LDB(B1, 0, 1); PG8_STAGE(PG8_SB(0, 0), b2, voffB);
            PG8_BAR; PG8_WAIT_L(0); PG8_MMA(0, 1, At, B1); PG8_BAR;
            PG8_LDA(At, 0, 1); PG8_STAGE(PG8_SA(0, 0), a2, voffA);
            PG8_BAR; PG8_WAIT_L(0); PG8_MMA(1, 0, At, B0); PG8_BAR; PG8_SCHED;
            PG8_STAGE(PG8_SB(0, 1), b2 + hstep, voffB);
            PG8_WAIT_V(6); PG8_BAR; PG8_MMA(1, 1, At, B1); PG8_BAR;
            PG8_LDB(B0, 1, 0); PG8_SCHED; PG8_LDA(At, 1, 0); PG8_STAGE(PG8_SA(0, 1), a2 + hstep, voffA);
            PG8_WAIT_L(8); PG8_BAR; PG8_WAIT_L(0); PG8_MMA(0, 0, At, B0); PG8_BAR; PG8_SCHED;
            PG8_LDB(B1, 1, 1); PG8_STAGE(PG8_SB(1, 0), b3, voffB);
            PG8_BAR; PG8_WAIT_L(0); PG8_MMA(0, 1, At, B1); PG8_BAR;
            PG8_LDA(At, 1, 1); PG8_STAGE(PG8_SA(1, 0), a3, voffA);
            PG8_BAR; PG8_WAIT_L(0); PG8_MMA(1, 0, At, B0); PG8_BAR; PG8_SCHED;
            PG8_STAGE(PG8_SB(1, 1), b3 + hstep, voffB);
            PG8_WAIT_V(6); PG8_BAR; PG8_MMA(1, 1, At, B1); PG8_BAR;
            }
        }
        if constexpr (ALIGN_EPI) { if (wr == 0) PG8_BAR; }
        if constexpr (!Epi::AFTER_DRAIN) { E(acc, cur, wr, wc, fr, fq); S.done(cur); }
        if (!has_next) break;
#pragma unroll
        for (int a = 0; a < 2; ++a)
#pragma unroll
            for (int b = 0; b < 2; ++b)
#pragma unroll
                for (int m = 0; m < 4; ++m)
#pragma unroll
                    for (int n = 0; n < 2; ++n) acc[a][b][m][n] = (f32x4){0.f, 0.f, 0.f, 0.f};
        cur = nxt; cA = nA; cB = nB; ++ui;
        if constexpr (ALIGN_EPI) { if (wr == 1) PG8_BAR; }
    }
    PG8_WAIT_V(0);
    if constexpr (!ALIGN_EPI) { if (wr == 0) PG8_BAR; }
    PG8_BAR;
    if constexpr (Epi::AFTER_DRAIN) { E.fused(acc, cur, wr, wc, fr, fq, lds, wid, lane); S.done(cur); }
#undef PG8_SA
#undef PG8_SB
#undef PG8_STAGE
#undef PG8_LDA
#undef PG8_LDB
#undef PG8_MMA
#undef PG8_WAIT_V
#undef PG8_WAIT_L
#undef PG8_BAR
#undef PG8_SCHED
}
}

#define LAS __attribute__((address_space(3)))
using pg8::bf16_t; using pg8::f32x4; using pg8::u32x4; using pg8::Unit;
typedef short bf16x8 __attribute__((ext_vector_type(8)));
typedef short s16x4 __attribute__((ext_vector_type(4)));
typedef short v4i16_t __attribute__((ext_vector_type(4)));
typedef float f32x16 __attribute__((ext_vector_type(16)));
typedef unsigned u32x2 __attribute__((ext_vector_type(2)));
typedef float f32x2_t __attribute__((ext_vector_type(2))); typedef __bf16 bf16x2_t __attribute__((ext_vector_type(2)));

constexpr int NWAVES = 8, NTHR = 512;
constexpr int DM = 1024, NB = 8, SEQ = 2048, DEPTH = 4, M = NB * SEQ;
constexpr int NHEAD = 24, MIXW = 1536, LDQ = 3 * MIXW  , NG = 3 * DM  , NQKVG = LDQ + NG  ;
constexpr int DFF = 2816, NGU = 2 * DFF;
constexpr float NORM_EPS = 1e-6f;
constexpr int LDS_BYTES = 147456;

constexpr size_t MiB = 1u << 20;
constexpr size_t WS_CTR = 0;
constexpr size_t WS_BAR = 32 * 1024;
constexpr size_t WS_MOD = 64 * 1024;
constexpr size_t WS_COS = WS_MOD + (size_t)DEPTH * NB * 6 * DM * 4;
constexpr size_t WS_SIN = WS_COS + (size_t)SEQ * 32 * 4;
constexpr size_t WS_KMEAN = WS_SIN + (size_t)SEQ * 32 * 4;
constexpr size_t WS_CNT = 2 * MiB;
constexpr size_t WS_XBUF = 2 * MiB + 256 * 1024;
constexpr size_t WS_W = 4 * MiB;
constexpr size_t W_QKVG = 0, W_A = W_QKVG + (size_t)NQKVG * DM * 2, W_B = W_A + (size_t)DM * 384 * 2, W_C = W_B + (size_t)DM * 384 * 2,
                 W_O = W_C + (size_t)DM * 384 * 2, W_GU = W_O + (size_t)DM * DM * 2, W_D = W_GU + (size_t)NGU * DM * 2, W_END = W_D + (size_t)DM * DFF * 2;
static_assert(W_END <= 40 * MiB, "weights");
constexpr size_t WS_H = 44 * MiB;
constexpr size_t WS_QKV = 76 * MiB;
constexpr size_t WS_GATES = 220 * MiB;
constexpr size_t WS_ATTA = 316 * MiB;
constexpr size_t WS_ATTB = WS_ATTA + (size_t)M * 384 * 2;
constexpr size_t WS_ATTC = WS_ATTB + (size_t)M * 384 * 2;
constexpr size_t WS_MERGED = 352 * MiB;
constexpr size_t WS_X16 = 384 * MiB;
constexpr size_t WS_END = 416 * MiB;

struct Params {
    const float *x, *c, *w_ada, *b_ada, *norm1_g, *w_in, *w_br_a, *w_br_b, *w_br_c, *w_gate, *b_gate, *w_out, *norm2_g, *w_gu, *w_down, *final_g;
    float* out; unsigned char* ws; int ph_lo, ph_hi;
};

__device__ __forceinline__ unsigned f2bf(float f) { unsigned u = __builtin_bit_cast(unsigned, f); return (u + 0x7fffu + ((u >> 16) & 1u)) >> 16; }
__device__ __forceinline__ unsigned pk2(float lo, float hi) { f32x2_t v = {lo, hi}; bf16x2_t b = __builtin_convertvector(v, bf16x2_t); return __builtin_bit_cast(unsigned, b); }
__device__ __forceinline__ float bf2f(unsigned short b) { return __uint_as_float((unsigned)b << 16); }
__device__ __forceinline__ float bflo(unsigned w) { return __uint_as_float(w << 16); }
__device__ __forceinline__ float bfhi(unsigned w) { return __uint_as_float(w & 0xffff0000u); }

template <int K> __device__ __forceinline__ float swz_xor(float v) { return __int_as_float(__builtin_amdgcn_ds_swizzle(__float_as_int(v), (K << 10) | 0x1f)); }
__device__ __forceinline__ float xor32_sum(float v) { auto rr = __builtin_amdgcn_permlane32_swap(__float_as_uint(v), __float_as_uint(v), false, false); return __uint_as_float(rr[0]) + __uint_as_float(rr[1]); }
__device__ __forceinline__ float xor32_max(float v) { auto rr = __builtin_amdgcn_permlane32_swap(__float_as_uint(v), __float_as_uint(v), false, false); return fmaxf(__uint_as_float(rr[0]), __uint_as_float(rr[1])); }
__device__ __forceinline__ float xor32_get(float v, int h) { auto rr = __builtin_amdgcn_permlane32_swap(__float_as_uint(v), __float_as_uint(v), false, false); return h == 0 ? __uint_as_float(rr[1]) : __uint_as_float(rr[0]); }
__device__ __forceinline__ float wave_sum(float v) {
    v += swz_xor<1>(v); v += swz_xor<2>(v); v += swz_xor<4>(v); v += swz_xor<8>(v); v += swz_xor<16>(v);
    return xor32_sum(v);
}
__device__ __forceinline__ float sigmoidf_(float x) { return __builtin_amdgcn_rcpf(1.0f + __expf(-x)); }


#define XB_TMO      128
#define XB_XCNT(j)  (256  + 64 * (j))
#define XB_XSUB(j)  (1280 + 64 * (j))
#define XB_XGEN(j)  (2304 + 64 * (j))
#define XB_TOP      3328
#define XB_TOPGEN   3392
#define XCD_BAR_WORDS 3456
#define XB_SPIN_CAP (1u << 22)
__device__ __forceinline__ unsigned xb_ld(unsigned* p)              { return __hip_atomic_load(p, __ATOMIC_RELAXED, __HIP_MEMORY_SCOPE_AGENT); }
__device__ __forceinline__ unsigned xb_add(unsigned* p, unsigned v) { return __hip_atomic_fetch_add(p, v, __ATOMIC_RELAXED, __HIP_MEMORY_SCOPE_AGENT); }
__device__ __forceinline__ unsigned xb_xcc_id() { return (unsigned)__builtin_amdgcn_s_getreg((3 << 11) | 20) & 0xFu; }
#define XB_SPIN(cond, bar) do { unsigned _sp = 0; while (cond) { __builtin_amdgcn_s_sleep(1); \
    if ((++_sp & 255u) == 0u) { if (xb_ld(&(bar)[XB_TMO])) break; if (_sp > XB_SPIN_CAP) { atomicAdd(&(bar)[XB_TMO], 1u); break; } } } } while (0)
struct XcdBarrier { unsigned* bar; unsigned x; volatile LAS unsigned* st; };
__device__ __forceinline__ XcdBarrier xcd_barrier_post(unsigned* bar, volatile LAS unsigned* st) {
    XcdBarrier b; b.bar = bar; b.x = xb_xcc_id(); b.st = st;
    if (threadIdx.x == 0) (void)xb_add(&bar[XB_XCNT(b.x)], 1u);
    return b;
}
__device__ __forceinline__ void xcd_barrier_complete(unsigned* bar, unsigned x, unsigned& nloc, unsigned& nx) {
    const unsigned G = gridDim.x * gridDim.y * gridDim.z;
    unsigned sum, cnt, mine, sp = 0u;
    for (;;) {
        sum = 0u; cnt = 0u; mine = 0u;
#pragma unroll
        for (unsigned j = 0; j < 16; ++j) { const unsigned c = xb_ld(&bar[XB_XCNT(j)]); sum += c; cnt += (c > 0u) ? 1u : 0u; mine = (j == x) ? c : mine; }
        if (sum == G) break;
        __builtin_amdgcn_s_sleep(1);
        if ((++sp & 255u) == 0u) { if (xb_ld(&bar[XB_TMO])) break; if (sp > XB_SPIN_CAP) { atomicAdd(&bar[XB_TMO], 1u); break; } }
    }
    nloc = mine > 0u ? mine : 1u; nx = cnt > 0u ? cnt : 1u;
}
__device__ __forceinline__ void xcd_barrier(unsigned* bar, volatile LAS unsigned* st, const int tid) {
    asm volatile("s_waitcnt vmcnt(0)" ::: "memory");
    __syncthreads();
    if (tid == 0) {
        const unsigned x = xb_xcc_id();
        __builtin_amdgcn_s_waitcnt(0);
        unsigned nloc = st[0], nx = st[1];
        if (nloc == 0u) { xcd_barrier_complete(bar, x, nloc, nx); st[0] = nloc; st[1] = nx; }
        const unsigned old = xb_add(&bar[XB_XSUB(x)], 1u);
        const unsigned gen = old / nloc;
        if (old + 1u == (gen + 1u) * nloc) {
            __builtin_amdgcn_fence(__ATOMIC_RELEASE, "agent");
            asm volatile("s_waitcnt vmcnt(0)" ::: "memory");
            const unsigned og = xb_add(&bar[XB_TOP], 1u);
            const unsigned tg = og / nx;
            if (og + 1u == (tg + 1u) * nx) xb_add(&bar[XB_TOPGEN], 1u);
            else XB_SPIN(xb_ld(&bar[XB_TOPGEN]) == tg, bar);
            __builtin_amdgcn_fence(__ATOMIC_ACQUIRE, "agent");
            xb_add(&bar[XB_XGEN(x)], 1u);
            asm volatile("s_waitcnt vmcnt(0)" ::: "memory");
        } else {
            XB_SPIN(xb_ld(&bar[XB_XGEN(x)]) == gen, bar);
            __builtin_amdgcn_fence(__ATOMIC_ACQUIRE, "agent");
            asm volatile("s_waitcnt vmcnt(0)" ::: "memory");
        }
    }
    __syncthreads();
}

struct EpiQKVG {
    static constexpr bool PERM = true, AFTER_DRAIN = false;
    bf16_t* qkv; bf16_t* gates; const float* bgate; const float* cosT; const float* sinT; float* kmean;
    __device__ __forceinline__ void operator()(const f32x4 (&acc)[2][2][4][2], const Unit& u, int wr, int wc, int fr, int fq) const {
        const int row0 = u.pm * 256 + wr * 64 + fr;
#pragma unroll
        for (int bj = 0; bj < 2; ++bj) {
            const int col = u.pn * 256 + bj * 128 + wc * 32 + 8 * fq;
            if (u.pn < 18) {
                const int which = col / MIXW, rem = col - which * MIXW, head = rem >> 6, dc = rem & 63;
                const bool rope = (which < 2) && (head < 18);
                const bool ksum_on = (which == 1) && (head >= 12) && (head < 18);
                const float sc = (which == 0) ? 0.125f * 1.4426950408889634f : 1.0f;
                if (rope) {
                    f32x4 c4[8], s4[8];
#pragma unroll
                    for (int i = 0; i < 8; ++i) { const int pos = (row0 + (i >> 2) * 128 + (i & 3) * 16) & (SEQ - 1);
                        c4[i] = *(const f32x4*)(cosT + (unsigned)(pos * 32 + (dc >> 1))); s4[i] = *(const f32x4*)(sinT + (unsigned)(pos * 32 + (dc >> 1))); }
                    float ks[8];
#pragma unroll
                    for (int j = 0; j < 8; ++j) ks[j] = 0.f;
#pragma unroll
                    for (int i = 0; i < 8; ++i) {
                        const int ai = i >> 2, m = i & 3, row = row0 + ai * 128 + m * 16;
                        const f32x4 v0 = acc[ai][bj][m][0], v1 = acc[ai][bj][m][1];
                        float r[8];
                        r[0] = v0[0] * c4[i][0] - v0[1] * s4[i][0]; r[1] = v0[0] * s4[i][0] + v0[1] * c4[i][0];
                        r[2] = v0[2] * c4[i][1] - v0[3] * s4[i][1]; r[3] = v0[2] * s4[i][1] + v0[3] * c4[i][1];
                        r[4] = v1[0] * c4[i][2] - v1[1] * s4[i][2]; r[5] = v1[0] * s4[i][2] + v1[1] * c4[i][2];
                        r[6] = v1[2] * c4[i][3] - v1[3] * s4[i][3]; r[7] = v1[2] * s4[i][3] + v1[3] * c4[i][3];
                        if (ksum_on) {
#pragma unroll
                            for (int j = 0; j < 8; ++j) ks[j] += r[j];
                        }
                        u32x4 w; w.x = pk2(r[0] * sc, r[1] * sc); w.y = pk2(r[2] * sc, r[3] * sc); w.z = pk2(r[4] * sc, r[5] * sc); w.w = pk2(r[6] * sc, r[7] * sc);
                        __builtin_nontemporal_store(w, (u32x4*)(qkv + (unsigned)(row * LDQ + col)));
                    }
                    if (ksum_on) {
#pragma unroll
                        for (int j = 0; j < 8; ++j) {
                            float v = ks[j];
                            v += swz_xor<1>(v); v += swz_xor<2>(v); v += swz_xor<4>(v); v += swz_xor<8>(v);
                            ks[j] = v;
                        }
                        if (fr == 0) {
                            float* dst = kmean + (size_t)(((u.pm >> 3) * 6 + (head - 12)) * 8 + (u.pm & 7)) * 64 + dc;
#pragma unroll
                            for (int j = 0; j < 8; ++j) atomicAdd(dst + j, ks[j]);
                        }
                    }
                } else {
#pragma unroll
                    for (int i = 0; i < 8; ++i) {
                        const int ai = i >> 2, m = i & 3, row = row0 + ai * 128 + m * 16;
                        const f32x4 v0 = acc[ai][bj][m][0] * sc, v1 = acc[ai][bj][m][1] * sc;
                        u32x4 w; w.x = pk2(v0[0], v0[1]); w.y = pk2(v0[2], v0[3]); w.z = pk2(v1[0], v1[1]); w.w = pk2(v1[2], v1[3]);
                        __builtin_nontemporal_store(w, (u32x4*)(qkv + (unsigned)(row * LDQ + col)));
                    }
                }
            } else {
                const int gcol = col - LDQ;
                const f32x4 b0 = *(const f32x4*)(bgate + gcol), b1 = *(const f32x4*)(bgate + gcol + 4);
#pragma unroll
                for (int ai = 0; ai < 2; ++ai)
#pragma unroll
                    for (int m = 0; m < 4; ++m) {
                        const int row = row0 + ai * 128 + m * 16;
                        const f32x4 v0 = acc[ai][bj][m][0] + b0, v1 = acc[ai][bj][m][1] + b1;
                        u32x4 w; w.x = pk2(sigmoidf_(v0[0]), sigmoidf_(v0[1])); w.y = pk2(sigmoidf_(v0[2]), sigmoidf_(v0[3]));
                        w.z = pk2(sigmoidf_(v1[0]), sigmoidf_(v1[1])); w.w = pk2(sigmoidf_(v1[2]), sigmoidf_(v1[3]));
                        __builtin_nontemporal_store(w, (u32x4*)(gates + (unsigned)(row * NG + gcol)));
                    }
            }
            asm volatile("" ::: "memory");
        }
    }
};
struct EpiBranch {
    static constexpr bool PERM = true, AFTER_DRAIN = false;
    const bf16_t* gates; bf16_t* merged;
    __device__ __forceinline__ void operator()(const f32x4 (&acc)[2][2][4][2], const Unit& us, int wr, int wc, int fr, int fq) const {
        const int br = us.pm >> 6; Unit u; u.pm = us.pm & 63; u.pn = us.pn & 3;
        const int row0 = u.pm * 256 + wr * 64 + fr;
#pragma unroll
        for (int ai = 0; ai < 2; ++ai)
#pragma unroll
            for (int m = 0; m < 4; ++m) {
                const int row = row0 + ai * 128 + m * 16;
#pragma unroll
                for (int bj = 0; bj < 2; ++bj) {
                    const int col = u.pn * 256 + bj * 128 + wc * 32 + 8 * fq;
                    const u32x4 g = *(const u32x4*)(gates + (unsigned)(row * NG + br * DM + col));
                    const f32x4 v0 = acc[ai][bj][m][0], v1 = acc[ai][bj][m][1];
                    float o[8];
                    o[0] = bflo(g.x) * v0[0]; o[1] = bfhi(g.x) * v0[1]; o[2] = bflo(g.y) * v0[2]; o[3] = bfhi(g.y) * v0[3];
                    o[4] = bflo(g.z) * v1[0]; o[5] = bfhi(g.z) * v1[1]; o[6] = bflo(g.w) * v1[2]; o[7] = bfhi(g.w) * v1[3];
                    bf16_t* dst = merged + (unsigned)(row * DM + col);
                    if (br > 0) {
                        const u32x4 p = *(const u32x4*)dst;
                        o[0] += bflo(p.x); o[1] += bfhi(p.x); o[2] += bflo(p.y); o[3] += bfhi(p.y);
                        o[4] += bflo(p.z); o[5] += bfhi(p.z); o[6] += bflo(p.w); o[7] += bfhi(p.w);
                    }
                    u32x4 w; w.x = pk2(o[0], o[1]); w.y = pk2(o[2], o[3]); w.z = pk2(o[4], o[5]); w.w = pk2(o[6], o[7]);
                    *(u32x4*)dst = w;
                }
                asm volatile("" ::: "memory");
            }
    }
};
struct RowStats {
    unsigned* xbuf;
    unsigned* cnt;
    __device__ __forceinline__ void run(const f32x4 (&v)[2][2][4][2], const Unit& u, int wr, int wc, int fr, int fq, LAS unsigned char* lds, int wid, int lane) const {
        LAS float* P = (LAS float*)lds;
        LAS float* S = (LAS float*)(lds + 4096);
#pragma unroll
        for (int ai = 0; ai < 2; ++ai)
#pragma unroll
            for (int m = 0; m < 4; ++m) {
                float q = 0.f;
#pragma unroll
                for (int bj = 0; bj < 2; ++bj)
#pragma unroll
                    for (int n = 0; n < 2; ++n) { const f32x4 x = v[ai][bj][m][n]; q += (x[0] * x[0] + x[1] * x[1]) + (x[2] * x[2] + x[3] * x[3]); }
                q += swz_xor<16>(q); q = xor32_sum(q);
                if (fq == 0) P[(ai * 128 + wr * 64 + m * 16 + fr) * 4 + wc] = q;
            }
        asm volatile("s_waitcnt lgkmcnt(0)" ::: "memory"); __builtin_amdgcn_s_barrier(); asm volatile("" ::: "memory");
        const int row = wid * 32 + (lane & 31);
        if (lane < 32) {
            const float t = (P[row * 4 + 0] + P[row * 4 + 1]) + (P[row * 4 + 2] + P[row * 4 + 3]);
            __hip_atomic_store(xbuf + ((size_t)(u.pm * 256 + row) * 4 + u.pn), __float_as_uint(t), __ATOMIC_RELAXED, __HIP_MEMORY_SCOPE_AGENT);
        }
        asm volatile("s_waitcnt vmcnt(0)" ::: "memory");
        if (lane == 0) __hip_atomic_fetch_add(cnt + 64 * u.pm, 1u, __ATOMIC_RELAXED, __HIP_MEMORY_SCOPE_AGENT);
        if (wid == 0) {
            unsigned sp = 0;
            for (;;) {
                if ((unsigned)__builtin_amdgcn_readfirstlane((int)__hip_atomic_load(cnt + 64 * u.pm, __ATOMIC_RELAXED, __HIP_MEMORY_SCOPE_AGENT)) >= 32u) break;
                if (++sp > (1u << 22)) break;
                __builtin_amdgcn_s_sleep(2);
            }
            __builtin_amdgcn_fence(__ATOMIC_ACQUIRE, "agent");
        }
        asm volatile("s_waitcnt vmcnt(0) lgkmcnt(0)" ::: "memory"); __builtin_amdgcn_s_barrier(); asm volatile("" ::: "memory");
        if (lane < 32) {
            const unsigned* slot = xbuf + (size_t)(u.pm * 256 + row) * 4;
            float t = 0.f;
#pragma unroll
            for (int k = 0; k < 4; ++k) t += __uint_as_float(__hip_atomic_load(slot + k, __ATOMIC_RELAXED, __HIP_MEMORY_SCOPE_AGENT));
            S[row] = 1.0f / sqrtf(t * (1.0f / DM) + NORM_EPS);
        }
        asm volatile("s_waitcnt lgkmcnt(0)" ::: "memory"); __builtin_amdgcn_s_barrier(); asm volatile("" ::: "memory");
    }
};
struct EpiResidNorm {
    static constexpr bool PERM = true, AFTER_DRAIN = true;
    const float* xin32; const bf16_t* xin16; bf16_t* xout16; float* yout; const float* gate; bf16_t* hout; const float* ng; const float* sc; const float* sh; RowStats st; int mode;
    __device__ __forceinline__ void operator()(const f32x4 (&)[2][2][4][2], const Unit&, int, int, int, int) const {}
    __device__ __forceinline__ void fused(f32x4 (&acc)[2][2][4][2], const Unit& u, int wr, int wc, int fr, int fq, LAS unsigned char* lds, int wid, int lane) const {
        const int row0 = u.pm * 256 + wr * 64 + fr;
        const unsigned boff = (unsigned)((u.pm >> 3) * 6 * DM);
#pragma unroll
        for (int bj = 0; bj < 2; ++bj) {
            const int col = u.pn * 256 + bj * 128 + wc * 32 + 8 * fq;
            const f32x4 g0 = *(const f32x4*)(gate + boff + col), g1 = *(const f32x4*)(gate + boff + col + 4);
            if (xin32) {
#pragma unroll
                for (int ai = 0; ai < 2; ++ai)
#pragma unroll
                    for (int m = 0; m < 4; ++m) {
                        const float* xp = xin32 + (unsigned)((row0 + ai * 128 + m * 16) * DM + col);
                        const f32x4 x0 = *(const f32x4*)xp, x1 = *(const f32x4*)(xp + 4);
                        acc[ai][bj][m][0] = x0 + g0 * acc[ai][bj][m][0]; acc[ai][bj][m][1] = x1 + g1 * acc[ai][bj][m][1];
                        asm volatile("" : "+v"(acc[ai][bj][m][0]), "+v"(acc[ai][bj][m][1]));
                        if (m & 1) asm volatile("" ::: "memory");
                    }
            } else {
#pragma unroll
                for (int ai = 0; ai < 2; ++ai)
#pragma unroll
                    for (int m = 0; m < 4; ++m) {
                        const u32x4 xw = *(const u32x4*)(xin16 + (unsigned)((row0 + ai * 128 + m * 16) * DM + col));
                        const f32x4 x0 = (f32x4){bflo(xw.x), bfhi(xw.x), bflo(xw.y), bfhi(xw.y)}, x1 = (f32x4){bflo(xw.z), bfhi(xw.z), bflo(xw.w), bfhi(xw.w)};
                        acc[ai][bj][m][0] = x0 + g0 * acc[ai][bj][m][0]; acc[ai][bj][m][1] = x1 + g1 * acc[ai][bj][m][1];
                        asm volatile("" : "+v"(acc[ai][bj][m][0]), "+v"(acc[ai][bj][m][1]));
                    }
            }
            asm volatile("" ::: "memory");
        }
        st.run(acc, u, wr, wc, fr, fq, lds, wid, lane);
        const LAS float* S = (const LAS float*)(lds + 4096);
#pragma unroll
        for (int bj = 0; bj < 2; ++bj) {
            const int col = u.pn * 256 + bj * 128 + wc * 32 + 8 * fq;
            f32x4 gv0 = *(const f32x4*)(ng + col), gv1 = *(const f32x4*)(ng + col + 4), sh0 = (f32x4){0.f, 0.f, 0.f, 0.f}, sh1 = sh0;
            if (mode == 0) { gv0 = gv0 * (*(const f32x4*)(sc + boff + col) + 1.0f); gv1 = gv1 * (*(const f32x4*)(sc + boff + col + 4) + 1.0f);
                             sh0 = *(const f32x4*)(sh + boff + col); sh1 = *(const f32x4*)(sh + boff + col + 4); }
#pragma unroll
            for (int ai = 0; ai < 2; ++ai)
#pragma unroll
                for (int m = 0; m < 4; ++m) {
                    const int r = ai * 128 + wr * 64 + m * 16 + fr;
                    const unsigned off = (unsigned)((u.pm * 256 + r) * DM + col);
                    const f32x4 x0 = acc[ai][bj][m][0], x1 = acc[ai][bj][m][1];
                    const float rs = S[r];
                    const f32x4 y0 = x0 * rs * gv0 + sh0, y1 = x1 * rs * gv1 + sh1;
                    if (mode == 0) {
                        u32x4 xw; xw.x = pk2(x0[0], x0[1]); xw.y = pk2(x0[2], x0[3]); xw.z = pk2(x1[0], x1[1]); xw.w = pk2(x1[2], x1[3]);
                        *(u32x4*)(xout16 + off) = xw;
                        u32x4 hw; hw.x = pk2(y0[0], y0[1]); hw.y = pk2(y0[2], y0[3]); hw.z = pk2(y1[0], y1[1]); hw.w = pk2(y1[2], y1[3]);
                        *(u32x4*)(hout + off) = hw;
                    } else {
                        *(f32x4*)(yout + off) = y0; *(f32x4*)(yout + off + 4) = y1;
                    }
                    if (m & 1) asm volatile("" ::: "memory");
                }
        }
    }
};
struct EpiSwiGLU {
    static constexpr bool PERM = true, AFTER_DRAIN = false;
    bf16_t* act;
    __device__ __forceinline__ void operator()(const f32x4 (&acc)[2][2][4][2], const Unit& u, int wr, int wc, int fr, int fq) const {
        const int row0 = u.pm * 256 + wr * 64 + fr;
        const int col = u.pn * 128 + wc * 32 + 8 * fq;
#pragma unroll
        for (int ai = 0; ai < 2; ++ai)
#pragma unroll
            for (int m = 0; m < 4; ++m) {
                const int row = row0 + ai * 128 + m * 16;
                float o[8];
#pragma unroll
                for (int n = 0; n < 2; ++n)
#pragma unroll
                    for (int j = 0; j < 4; ++j) { const float gt = acc[ai][0][m][n][j], up = acc[ai][1][m][n][j]; o[4 * n + j] = gt * sigmoidf_(gt) * up; }
                u32x4 w; w.x = pk2(o[0], o[1]); w.y = pk2(o[2], o[3]); w.z = pk2(o[4], o[5]); w.w = pk2(o[6], o[7]);
                __builtin_nontemporal_store(w, (u32x4*)(act + (unsigned)(row * DFF + col)));
                asm volatile("" ::: "memory");
            }
    }
};

struct BranchOrder {
    pg8::StaticOrder base;
    __device__ __forceinline__ bool next(int i, Unit& u) const { Unit t; if (!base.next(i / 3, t)) return false; const int br = i % 3; u.pm = br * 64 + t.pm; u.pn = br * 4 + t.pn; return true; }
    __device__ __forceinline__ void a_ready(const Unit&) const {}
    __device__ __forceinline__ void done(const Unit&) const {}
};
struct LimitOrder {
    pg8::StaticOrder base; int lim;
    __device__ __forceinline__ bool next(int i, Unit& u) const { return i < lim && base.next(i, u); }
    __device__ __forceinline__ void a_ready(const Unit&) const {}
    __device__ __forceinline__ void done(const Unit&) const {}
};
struct OneUnit {
    Unit u0;
    __device__ __forceinline__ bool next(int i, Unit& u) const { if (i != 0) return false; u = u0; return true; }
    __device__ __forceinline__ void a_ready(const Unit&) const {}
    __device__ __forceinline__ void done(const Unit&) const {}
};
__device__ __forceinline__ int rowmap(int kind, int n) {
    if (kind == 1) { const int which = n / MIXW, rem = n - which * MIXW, head = rem >> 6, d = rem & 63;
        const int dd = (which < 2 && head < 18) ? (2 * (d & 31) + (d >> 5)) : d; return which * MIXW + head * 64 + dd; }
    if (kind == 2) { const int up = n >= DFF, j = up ? n - DFF : n; return (j >> 7) * 256 + up * 128 + (j & 127); }
    return n;
}
__device__ __forceinline__ void transpose_item(const float* W, int K, int N, bf16_t* WT, int ldk, int row_off, int kind, LAS float* scr, int item, int lane) {
    const int nblk = N / 32, kb = item / nblk, nb = item % nblk, k0 = 64 * kb, n0 = 32 * nb;
#pragma unroll 8
    for (int i = 0; i < 32; ++i) { const int kk = 2 * i + (lane >> 5); scr[kk * 33 + (lane & 31)] = W[(size_t)(k0 + kk) * N + n0 + (lane & 31)]; }
    asm volatile("s_waitcnt lgkmcnt(0)" ::: "memory");
    const int c = lane & 7;
#pragma unroll
    for (int j = 0; j < 4; ++j) { const int n = (lane >> 3) + 8 * j; const LAS float* s = scr + (8 * c) * 33 + n;
        u32x4 o; o.x = pk2(s[0 * 33], s[1 * 33]); o.y = pk2(s[2 * 33], s[3 * 33]); o.z = pk2(s[4 * 33], s[5 * 33]); o.w = pk2(s[6 * 33], s[7 * 33]);
        *(u32x4*)(WT + (size_t)(row_off + rowmap(kind, n0 + n)) * ldk + k0 + 8 * c) = o; }
    asm volatile("s_waitcnt lgkmcnt(0)" ::: "memory");
}

#define MFMA32(a, b, c) __builtin_amdgcn_mfma_f32_32x32x16_bf16((a), (b), (c), 0, 0, 0)
constexpr int VROW = 144;
constexpr int VTILE = 32 * VROW;
__device__ __forceinline__ int crow(int r, int h) { return (r & 3) + 8 * (r >> 2) + 4 * h; }
__device__ __forceinline__ s16x4 vtr(const LAS unsigned char* p) { return __builtin_bit_cast(s16x4, __builtin_amdgcn_ds_read_tr16_b64_v4i16((LAS v4i16_t*)p)); }

struct WaveCtx { int lane, q, h; LAS unsigned char* vl; int troff; };

__device__ __forceinline__ void load_q(bf16x8 (&qf)[4], const bf16_t* qrow, int h) {
#pragma unroll
    for (int ks = 0; ks < 4; ++ks) qf[ks] = *(const bf16x8*)(qrow + 16 * ks + 8 * h);
}
template <bool CLAMP>
__device__ __forceinline__ void load_k(bf16x8 (&kf)[4], const bf16_t* kbase, int k0, int kst, const WaveCtx& c) {
    int kp = k0 + kst * c.q; if (CLAMP) kp = kp < 0 ? 0 : (kp > SEQ - 1 ? SEQ - 1 : kp);
    const bf16_t* kr = kbase + (size_t)kp * LDQ + 8 * c.h;
#pragma unroll
    for (int ks = 0; ks < 4; ++ks) kf[ks] = *(const bf16x8*)(kr + 16 * ks);
}
template <bool CLAMP>
__device__ __forceinline__ void load_v(u32x4 (&vr)[4], const bf16_t* vbase, int k0, int kst, const WaveCtx& c) {
#pragma unroll
    for (int i = 0; i < 4; ++i) { const int p = c.lane + 64 * i, n = p >> 3; int kp = k0 + kst * n; if (CLAMP) kp = kp < 0 ? 0 : (kp > SEQ - 1 ? SEQ - 1 : kp);
        vr[i] = *(const u32x4*)(vbase + (size_t)kp * LDQ + (p & 7) * 8); }
}
__device__ __forceinline__ void store_v(const u32x4 (&vr)[4], const WaveCtx& c) {
#pragma unroll
    for (int i = 0; i < 4; ++i) { const int p = c.lane + 64 * i, n = p >> 3; *(LAS u32x4*)(c.vl + n * VROW + (p & 7) * 16) = vr[i]; }
}
struct VF { bf16x8 v[2][2]; };
__device__ __forceinline__ void read_vf_at(VF& f, const LAS unsigned char* vb, const WaveCtx& c) {
#pragma unroll
    for (int dt = 0; dt < 2; ++dt)
#pragma unroll
        for (int s2 = 0; s2 < 2; ++s2) {
            const LAS unsigned char* a = vb + c.troff + (16 * s2) * VROW + dt * 64;
            const s16x4 lo = vtr(a), hi = vtr(a + 8 * VROW);
            f.v[dt][s2] = (bf16x8){lo[0], lo[1], lo[2], lo[3], hi[0], hi[1], hi[2], hi[3]};
        }
}
__device__ __forceinline__ void read_vf(VF& f, const WaveCtx& c) {
#pragma unroll
    for (int dt = 0; dt < 2; ++dt)
#pragma unroll
        for (int s2 = 0; s2 < 2; ++s2) {
            const LAS unsigned char* a = c.vl + c.troff + (16 * s2) * VROW + dt * 64;
            const s16x4 lo = vtr(a), hi = vtr(a + 8 * VROW);
            f.v[dt][s2] = (bf16x8){lo[0], lo[1], lo[2], lo[3], hi[0], hi[1], hi[2], hi[3]};
        }
}
__device__ __forceinline__ void pv(f32x16 (&o)[2], const f32x16& p, const VF& f) {
    bf16x8 pb[2];
#pragma unroll
    for (int s2 = 0; s2 < 2; ++s2) {
        u32x4 w; w.x = pk2(p[8 * s2 + 0], p[8 * s2 + 1]); w.y = pk2(p[8 * s2 + 2], p[8 * s2 + 3]); w.z = pk2(p[8 * s2 + 4], p[8 * s2 + 5]); w.w = pk2(p[8 * s2 + 6], p[8 * s2 + 7]);
        pb[s2] = __builtin_bit_cast(bf16x8, w);
    }
#pragma unroll
    for (int s2 = 0; s2 < 2; ++s2)
#pragma unroll
        for (int dt = 0; dt < 2; ++dt) o[dt] = MFMA32(f.v[dt][s2], pb[s2], o[dt]);
}
__device__ __forceinline__ f32x16 qk(const bf16x8 (&kf)[4], const bf16x8 (&qf)[4]) {
    f32x16 s0, s1;
#pragma unroll
    for (int r = 0; r < 16; ++r) { s0[r] = 0.f; s1[r] = 0.f; }
    s0 = MFMA32(kf[0], qf[0], s0); s1 = MFMA32(kf[2], qf[2], s1);
    s0 = MFMA32(kf[1], qf[1], s0); s1 = MFMA32(kf[3], qf[3], s1);
    return s0 + s1;
}
__device__ __forceinline__ f32x16 qk_ref(const bf16x8 (&kf)[4], const bf16x8 (&qf)[4], const f32x16& negm) {
    f32x16 s = MFMA32(kf[0], qf[0], negm);
    s = MFMA32(kf[1], qf[1], s); s = MFMA32(kf[2], qf[2], s); s = MFMA32(kf[3], qf[3], s);
    return s;
}
struct SoftState { f32x16 o[2]; f32x16 negm; float m, l; };
struct KV { bf16x8 kf[4]; u32x4 vr[4]; };
template <bool CLAMP>
__device__ __forceinline__ void issue_kv(KV& t, const bf16_t* kbase, const bf16_t* vbase, int k0, int kst, const WaveCtx& c) { load_k<CLAMP>(t.kf, kbase, k0, kst, c); load_v<CLAMP>(t.vr, vbase, k0, kst, c); }
__device__ __forceinline__ void soft_init(SoftState& st) {
#pragma unroll
    for (int r = 0; r < 16; ++r) { st.o[0][r] = 0.f; st.o[1][r] = 0.f; }
    st.m = 0.f; st.l = 0.f;
#pragma unroll
    for (int r = 0; r < 16; ++r) st.negm[r] = 0.f;
}
template <int MODE>
__device__ __forceinline__ void soft_compute(SoftState& st, const bf16x8 (&qf)[4], const KV& t, int k0, int kst, int qp, int W, int dilm1, bool lane_ok, bool diag, const WaveCtx& c) {
    store_v(t.vr, c);
    VF vf; read_vf(vf, c);
    f32x16 s = qk_ref(t.kf, qf, st.negm);
    if (MODE == 0) {
        const int relb = qp - k0;
        const bool cls_ok = ((relb & dilm1) == 0);
#pragma unroll
        for (int r = 0; r < 16; ++r) {
            const unsigned rel = (unsigned)(relb - kst * crow(r, c.h));
            s[r] = (cls_ok && rel <= (unsigned)W) ? s[r] : -1e30f;
        }

    } else if (diag) {
#pragma unroll
        for (int r = 0; r < 16; ++r) { const int kp = k0 + crow(r, c.h); s[r] = (kp <= qp) ? s[r] : -1e30f; }
    } else if (__ballot(!lane_ok) != 0ull) {
#pragma unroll
        for (int r = 0; r < 16; ++r) s[r] = lane_ok ? s[r] : -1e30f;
    }
    float mx = fmaxf(fmaxf(s[0], s[1]), fmaxf(s[2], s[3]));
#pragma unroll
    for (int r = 4; r < 16; r += 4) mx = fmaxf(mx, fmaxf(fmaxf(s[r], s[r + 1]), fmaxf(s[r + 2], s[r + 3])));
    mx = xor32_max(mx);
    if (__ballot(mx > 8.0f) != 0ull) {
        const float d = fmaxf(mx, 0.f), scl = __builtin_amdgcn_exp2f(-d);
        st.l *= scl; st.m += d;
        const float nm = -st.m;
#pragma unroll
        for (int r = 0; r < 16; ++r) { st.o[0][r] *= scl; st.o[1][r] *= scl; s[r] -= d; st.negm[r] = nm; }
    }
    float ps = 0.f;
#pragma unroll
    for (int r = 0; r < 16; ++r) { const float p = __builtin_amdgcn_exp2f(s[r]); s[r] = p; ps += p; }
    st.l += xor32_sum(ps);
    pv(st.o, s, vf);
}
__device__ __forceinline__ void store_o(const f32x16 (&o)[2], float inv, bf16_t* orow, const WaveCtx& c) {
#pragma unroll
    for (int dt = 0; dt < 2; ++dt)
#pragma unroll
        for (int r4 = 0; r4 < 4; ++r4) {
            u32x2 w; w.x = pk2(o[dt][4 * r4] * inv, o[dt][4 * r4 + 1] * inv); w.y = pk2(o[dt][4 * r4 + 2] * inv, o[dt][4 * r4 + 3] * inv);
            *(u32x2*)(orow + 32 * dt + 8 * r4 + 4 * c.h) = w;
        }
}

__device__ __forceinline__ void unit_A(const bf16_t* qkv, bf16_t* outA, int b, int slot, int blk, int w, const WaveCtx& c) {
    const int cls0 = (w & 3) + 8 * (w >> 2), cls = cls0 + 4 * (c.q >> 4), qp = 256 * blk + cls + 16 * (c.q & 15);
    const bf16_t* rowb = qkv + (size_t)b * SEQ * LDQ;
    SoftState st; soft_init(st);
    for (int g = 0; g < 3; ++g) {
        const int dil = 1 << (2 * g), W = 128 * dil, head = 4 * g + slot;
        bf16x8 qf[4]; load_q(qf, rowb + (size_t)qp * LDQ + head * 64, c.h);
        const bf16_t* kbase = rowb + MIXW + head * 64; const bf16_t* vbase = rowb + 2 * MIXW + head * 64;
        int ks0, ks1 = 0, n0, n1 = 0;
        if (g == 0) { ks0 = 256 * blk + cls0 - 128; if (ks0 < 0) ks0 = 0; const int kend = 256 * blk + cls0 + 4 + 240; n0 = ((kend - ks0) + 1 + 31) >> 5; }
        else if (g == 1) {
            const int lo = 256 * blk - W;
            ks0 = (lo < 0) ? (cls0 & 3) : (cls0 + lo);
            n0 = ((256 * blk + cls0 + 4 + 240 - ks0) / dil + 1 + 31) >> 5;
        } else {
            const int lo = 256 * blk - W;
            const int c0 = cls0, c1 = cls0 + 4;
            ks0 = (lo < 0) ? (c0 & (dil - 1)) : (c0 + lo); ks1 = (lo < 0) ? (c1 & (dil - 1)) : (c1 + lo);
            n0 = ((256 * blk + c0 + 240 - ks0) / dil + 1 + 31) >> 5; n1 = ((256 * blk + c1 + 240 - ks1) / dil + 1 + 31) >> 5;
        }
        const int ntot = n0 + n1, step = 32 * dil;
        KV ta, tb;
        issue_kv<true>(ta, kbase, vbase, ks0, dil, c);
#define A_K0(i) (((i) < n0) ? (ks0 + step * (i)) : (ks1 + step * ((i) - n0)))
        for (int i = 0; i < ntot; i += 2) {
            if (i + 1 < ntot) issue_kv<true>(tb, kbase, vbase, A_K0(i + 1), dil, c);
            soft_compute<0>(st, qf, ta, A_K0(i), dil, qp, W, dil - 1, true, false, c);
            if (i + 1 >= ntot) break;
            if (i + 2 < ntot) issue_kv<true>(ta, kbase, vbase, A_K0(i + 2), dil, c);
            soft_compute<0>(st, qf, tb, A_K0(i + 1), dil, qp, W, dil - 1, true, false, c);
        }
#undef A_K0
    }
    store_o(st.o, __builtin_amdgcn_rcpf(st.l), outA + (size_t)(b * SEQ + qp) * 384 + slot * 64, c);
}
constexpr int A2_T = 40960, A2_STRIDE = 68, A2_M = A2_T + 256 * A2_STRIDE * 4, A2_L = A2_M + 1024;
__device__ __forceinline__ void unit_A2(const bf16_t* qkv, bf16_t* outA, int b, int slot, int blk, int w, LAS unsigned char* lds, const WaveCtx& c) {
    const bf16_t* rowb = qkv + (size_t)b * SEQ * LDQ;
    SoftState st; soft_init(st);
    {
        const int qp1 = 256 * blk + 32 * w + c.q, head = slot;
        bf16x8 qf[4]; load_q(qf, rowb + (size_t)qp1 * LDQ + head * 64, c.h);
        const bf16_t* kbase = rowb + MIXW + head * 64; const bf16_t* vbase = rowb + 2 * MIXW + head * 64;
        int ks0 = 256 * blk + 32 * w - 128; if (ks0 < 0) ks0 = 0;
        const int ntot = ((256 * blk + 32 * w + 31 - ks0) + 1 + 31) >> 5;
        KV ta, tb;
        issue_kv<true>(ta, kbase, vbase, ks0, 1, c);
        for (int i = 0; i < ntot; i += 2) {
            if (i + 1 < ntot) issue_kv<true>(tb, kbase, vbase, ks0 + 32 * (i + 1), 1, c);
            soft_compute<0>(st, qf, ta, ks0 + 32 * i, 1, qp1, 128, 0, true, false, c);
            if (i + 1 >= ntot) break;
            if (i + 2 < ntot) issue_kv<true>(ta, kbase, vbase, ks0 + 32 * (i + 2), 1, c);
            soft_compute<0>(st, qf, tb, ks0 + 32 * (i + 1), 1, qp1, 128, 0, true, false, c);
        }
    }
    LAS float* T = (LAS float*)(lds + A2_T); LAS float* Mt = (LAS float*)(lds + A2_M); LAS float* Lt = (LAS float*)(lds + A2_L);
    {
        const int qi = 32 * w + c.q;
#pragma unroll
        for (int dt = 0; dt < 2; ++dt)
#pragma unroll
            for (int r4 = 0; r4 < 4; ++r4)
                *(LAS f32x4*)(T + qi * A2_STRIDE + 32 * dt + 8 * r4 + 4 * c.h) = (f32x4){st.o[dt][4 * r4], st.o[dt][4 * r4 + 1], st.o[dt][4 * r4 + 2], st.o[dt][4 * r4 + 3]};
        if (c.h == 0) { Mt[qi] = st.m; Lt[qi] = st.l; }
    }
    __syncthreads();
    const int cls0 = (w & 3) + 8 * (w >> 2), cls = cls0 + 4 * (c.q >> 4), qi2 = cls + 16 * (c.q & 15), qp = 256 * blk + qi2;
    {
#pragma unroll
        for (int dt = 0; dt < 2; ++dt)
#pragma unroll
            for (int r4 = 0; r4 < 4; ++r4) {
                const f32x4 v = *(const LAS f32x4*)(T + qi2 * A2_STRIDE + 32 * dt + 8 * r4 + 4 * c.h);
                st.o[dt][4 * r4] = v[0]; st.o[dt][4 * r4 + 1] = v[1]; st.o[dt][4 * r4 + 2] = v[2]; st.o[dt][4 * r4 + 3] = v[3];
            }
        st.m = Mt[qi2]; st.l = Lt[qi2];
        const float nm = -st.m;
#pragma unroll
        for (int r = 0; r < 16; ++r) st.negm[r] = nm;
    }
    for (int g = 1; g < 3; ++g) {
        const int dil = 1 << (2 * g), W = 128 * dil, head = 4 * g + slot;
        bf16x8 qf[4]; load_q(qf, rowb + (size_t)qp * LDQ + head * 64, c.h);
        const bf16_t* kbase = rowb + MIXW + head * 64; const bf16_t* vbase = rowb + 2 * MIXW + head * 64;
        int ks0, ks1 = 0, n0, n1 = 0;
        const int lo = 256 * blk - W;
        if (g == 1) { ks0 = (lo < 0) ? (cls0 & 3) : (cls0 + lo); n0 = ((256 * blk + cls0 + 4 + 240 - ks0) / dil + 1 + 31) >> 5; }
        else { const int c0 = cls0, c1 = cls0 + 4;
            ks0 = (lo < 0) ? (c0 & (dil - 1)) : (c0 + lo); ks1 = (lo < 0) ? (c1 & (dil - 1)) : (c1 + lo);
            n0 = ((256 * blk + c0 + 240 - ks0) / dil + 1 + 31) >> 5; n1 = ((256 * blk + c1 + 240 - ks1) / dil + 1 + 31) >> 5; }
        const int ntot = n0 + n1, step = 32 * dil;
        KV ta, tb;
        issue_kv<true>(ta, kbase, vbase, ks0, dil, c);
#define A_K0(i) (((i) < n0) ? (ks0 + step * (i)) : (ks1 + step * ((i) - n0)))
        for (int i = 0; i < ntot; i += 2) {
            if (i + 1 < ntot) issue_kv<true>(tb, kbase, vbase, A_K0(i + 1), dil, c);
            soft_compute<0>(st, qf, ta, A_K0(i), dil, qp, W, dil - 1, true, false, c);
            if (i + 1 >= ntot) break;
            if (i + 2 < ntot) issue_kv<true>(ta, kbase, vbase, A_K0(i + 2), dil, c);
            soft_compute<0>(st, qf, tb, A_K0(i + 1), dil, qp, W, dil - 1, true, false, c);
        }
#undef A_K0
    }
    store_o(st.o, __builtin_amdgcn_rcpf(st.l), outA + (size_t)(b * SEQ + qp) * 384 + slot * 64, c);
}
__device__ __forceinline__ void soft_compute_lds(SoftState& st, const bf16x8 (&qf)[4], const LAS unsigned char* kc, const LAS unsigned char* vc, int k0, int qp, bool lane_ok, bool diag, const WaveCtx& c) {
    bf16x8 kf[4];
#pragma unroll
    for (int ks = 0; ks < 4; ++ks) kf[ks] = *(const LAS bf16x8*)(kc + c.q * VROW + ks * 32 + c.h * 16);
    f32x16 s = qk_ref(kf, qf, st.negm);
    if (diag) {
#pragma unroll
        for (int r = 0; r < 16; ++r) { const int kp = k0 + crow(r, c.h); s[r] = (kp <= qp) ? s[r] : -1e30f; }
    } else if (__ballot(!lane_ok) != 0ull) {
#pragma unroll
        for (int r = 0; r < 16; ++r) s[r] = lane_ok ? s[r] : -1e30f;
    }
    float mx = fmaxf(fmaxf(s[0], s[1]), fmaxf(s[2], s[3]));
#pragma unroll
    for (int r = 4; r < 16; r += 4) mx = fmaxf(mx, fmaxf(fmaxf(s[r], s[r + 1]), fmaxf(s[r + 2], s[r + 3])));
    mx = xor32_max(mx);
    if (__ballot(mx > 8.0f) != 0ull) {
        const float d = fmaxf(mx, 0.f), scl = __builtin_amdgcn_exp2f(-d);
        st.l *= scl; st.m += d;
        const float nm = -st.m;
#pragma unroll
        for (int r = 0; r < 16; ++r) { st.o[0][r] *= scl; st.o[1][r] *= scl; s[r] -= d; st.negm[r] = nm; }
    }
    float ps = 0.f;
#pragma unroll
    for (int r = 0; r < 16; ++r) { const float p = __builtin_amdgcn_exp2f(s[r]); s[r] = p; ps += p; }
    st.l += xor32_sum(ps);
    VF vf; read_vf_at(vf, vc, c);
    pv(st.o, s, vf);
}
constexpr int BST = 128 * VROW;
__device__ __forceinline__ void wg_unit_B(const bf16_t* qkv, const float* kmean, bf16_t* outB, int b, int hb, int qb, LAS unsigned char* lds, int wid, const WaveCtx& c, int tid) {
    const int own = qb, qt = 8 * qb + wid, qp = 32 * qt + c.q, head = 12 + hb;
    const bf16_t* rowb = qkv + (size_t)b * SEQ * LDQ;
    bf16x8 qf[4]; load_q(qf, rowb + (size_t)qp * LDQ + head * 64, c.h);
    const bf16_t* kbase = rowb + MIXW + head * 64; const bf16_t* vbase = rowb + 2 * MIXW + head * 64;
    float gate[7];
#pragma unroll
    for (int n = 0; n < 7; ++n) {
        gate[n] = -INFINITY;
        if (n < own) {
            const float* km = kmean + (size_t)((b * 6 + hb) * 8 + n) * 64 + 8 * c.h;
            float a = 0.f;
#pragma unroll
            for (int ks = 0; ks < 4; ++ks) {
                const f32x4 k0 = *(const f32x4*)(km + 16 * ks), k1 = *(const f32x4*)(km + 16 * ks + 4);
#pragma unroll
                for (int j = 0; j < 4; ++j) { a += bf2f((unsigned short)qf[ks][j]) * k0[j]; a += bf2f((unsigned short)qf[ks][4 + j]) * k1[j]; }
            }
            a = xor32_sum(a);
            gate[n] = a;
        }
    }
    unsigned sel = 0;
#pragma unroll
    for (int n = 0; n < 7; ++n) {
        if (n < own) {
            int rank = 0;
#pragma unroll
            for (int m2 = 0; m2 < 7; ++m2) if (m2 < own && m2 != n) rank += (gate[m2] > gate[n] || (gate[m2] == gate[n] && m2 < n)) ? 1 : 0;
            if (rank < 3) sel |= 1u << n;
        }
    }
    unsigned vis = 0;
#pragma unroll
    for (int n = 0; n < 7; ++n) if (n < own && __ballot((sel >> n) & 1u) != 0ull) vis |= 1u << n;
    LAS unsigned* wv = (LAS unsigned*)(lds + 131072 + 128);
    if (tid == 0) *wv = 0u;
    __syncthreads();
    if (c.lane == 0 && vis) __hip_atomic_fetch_or((unsigned*)wv, vis, __ATOMIC_RELAXED, __HIP_MEMORY_SCOPE_WORKGROUP);
    __syncthreads();
    const unsigned visw = *wv;
    const int nsteps = 2 * (__popc(visw) + 1);
    const int srow = tid >> 3, spc = tid & 7;
    u32x4 kr[2], vr[2];
#define BW_LOAD(blk_, half_) do { const int r0_ = 256 * (blk_) + 128 * (half_) + srow; \
        kr[0] = *(const u32x4*)(kbase + (size_t)r0_ * LDQ + spc * 8); kr[1] = *(const u32x4*)(kbase + (size_t)(r0_ + 64) * LDQ + spc * 8); \
        vr[0] = *(const u32x4*)(vbase + (size_t)r0_ * LDQ + spc * 8); vr[1] = *(const u32x4*)(vbase + (size_t)(r0_ + 64) * LDQ + spc * 8); } while (0)
#define BW_WRITE(buf_) do { LAS unsigned char* kb_ = lds + (buf_) * 2 * BST; LAS unsigned char* vb_ = kb_ + BST; \
        *(LAS u32x4*)(kb_ + srow * VROW + spc * 16) = kr[0]; *(LAS u32x4*)(kb_ + (srow + 64) * VROW + spc * 16) = kr[1]; \
        *(LAS u32x4*)(vb_ + srow * VROW + spc * 16) = vr[0]; *(LAS u32x4*)(vb_ + (srow + 64) * VROW + spc * 16) = vr[1]; } while (0)
    SoftState st; soft_init(st);
    unsigned rem = visw; int blk = rem ? (int)__builtin_ctz(rem) : own, half = 0;
    BW_LOAD(blk, 0); BW_WRITE(0);
    __syncthreads();
    for (int sidx = 0; sidx < nsteps; ++sidx) {
        int nblk = blk, nhalf = half ^ 1; unsigned nrem = rem;
        if (half == 1) { nrem = rem & (rem - 1u); nblk = nrem ? (int)__builtin_ctz(nrem) : own; }
        const bool has_next = (sidx + 1 < nsteps);
        if (has_next) BW_LOAD(nblk, nhalf);
        const LAS unsigned char* kst = lds + (sidx & 1) * 2 * BST; const LAS unsigned char* vst = kst + BST;
        if (blk == own) {
#pragma unroll 1
            for (int ch = 0; ch < 4; ++ch) { const int ci = 4 * half + ch;
                if (ci <= wid) soft_compute_lds(st, qf, kst + ch * 32 * VROW, vst + ch * 32 * VROW, 256 * blk + 32 * ci, qp, true, ci == wid, c); }
        } else if ((vis >> blk) & 1u) {
            const bool mine = ((sel >> blk) & 1u) != 0u;
#pragma unroll 1
            for (int ch = 0; ch < 4; ++ch) soft_compute_lds(st, qf, kst + ch * 32 * VROW, vst + ch * 32 * VROW, 256 * blk + 128 * half + 32 * ch, qp, mine, false, c);
        }
        if (has_next) BW_WRITE((sidx + 1) & 1);
        __syncthreads();
        blk = nblk; half = nhalf; rem = nrem;
    }
#undef BW_LOAD
#undef BW_WRITE
    store_o(st.o, __builtin_amdgcn_rcpf(st.l), outB + (size_t)(b * SEQ + qp) * 384 + hb * 64, c);
}
__device__ __forceinline__ void unit_C(const bf16_t* qkv, bf16_t* outC, int b, int hc, int qt, const WaveCtx& c) {
    const int qp = 32 * qt + c.q, head = 18 + hc;
    const bf16_t* rowb = qkv + (size_t)b * SEQ * LDQ;
    bf16x8 qf[4]; load_q(qf, rowb + (size_t)qp * LDQ + head * 64, c.h);
    const bf16_t* kbase = rowb + MIXW + head * 64; const bf16_t* vbase = rowb + 2 * MIXW + head * 64;
    f32x16 o[2];
#pragma unroll
    for (int r = 0; r < 16; ++r) { o[0][r] = 0.f; o[1][r] = 0.f; }
    float carry = 0.f;
    KV ta, tb;
    issue_kv<false>(ta, kbase, vbase, 32 * qt, 1, c);
    bool done = false;
#define C_STEP(T, ch) do { \
        const int k0 = 32 * (ch); \
        store_v(T.vr, c); VF vf; read_vf(vf, c); \
        f32x16 z = qk(T.kf, qf); \
        float lk[16], gs[4]; \
        const bool diag = ((ch) == qt); \
        _Pragma("unroll") for (int r = 0; r < 16; ++r) { \
            const bool ok = diag ? ((k0 + crow(r, c.h)) < qp) : true; \
            const float zz = z[r], sp = fmaxf(zz, 0.f) + __builtin_amdgcn_logf(1.0f + __builtin_amdgcn_exp2f(-fabsf(zz)));   \
            lk[r] = ok ? -sp : 0.f; \
            z[r] = ok ? (zz - sp) : -1e30f; } \
        _Pragma("unroll") for (int g4 = 0; g4 < 4; ++g4) gs[g4] = (lk[4 * g4] + lk[4 * g4 + 1]) + (lk[4 * g4 + 2] + lk[4 * g4 + 3]); \
        float os[4]; \
        _Pragma("unroll") for (int g4 = 0; g4 < 4; ++g4) os[g4] = xor32_get(gs[g4], c.h); \
        float T_ = 0.f; \
        _Pragma("unroll") for (int g4 = 3; g4 >= 0; --g4) { \
            const float base = carry + T_ + (c.h == 0 ? os[g4] : 0.f); \
            const float a3 = base, a2 = a3 + lk[4 * g4 + 3], a1 = a2 + lk[4 * g4 + 2], a0 = a1 + lk[4 * g4 + 1]; \
            z[4 * g4 + 3] = __builtin_amdgcn_exp2f(z[4 * g4 + 3] + a3); z[4 * g4 + 2] = __builtin_amdgcn_exp2f(z[4 * g4 + 2] + a2); \
            z[4 * g4 + 1] = __builtin_amdgcn_exp2f(z[4 * g4 + 1] + a1); z[4 * g4 + 0] = __builtin_amdgcn_exp2f(z[4 * g4 + 0] + a0); \
            T_ += gs[g4] + os[g4]; } \
        carry += T_; \
        pv(o, z, vf); \
        done = (__ballot(carry > -150.5f) == 0ull);   } while (0)
    for (int ch = qt; ch >= 0; ch -= 2) {
        if (ch > 0) issue_kv<false>(tb, kbase, vbase, 32 * (ch - 1), 1, c);
        C_STEP(ta, ch);
        if (done || ch == 0) break;
        if (ch > 1) issue_kv<false>(ta, kbase, vbase, 32 * (ch - 2), 1, c);
        C_STEP(tb, ch - 1);
        if (done) break;
    }
#undef C_STEP
    store_o(o, 1.0f, outC + (size_t)(b * SEQ + qp) * 384 + hc * 64, c);
}

__device__ __forceinline__ void attn_phase(const Params& p, unsigned char* ws, int layer, LAS unsigned char* lds, const int tid, int rep) {
    const int wid = __builtin_amdgcn_readfirstlane(tid >> 6);
    const bf16_t* qkv = (const bf16_t*)(ws + WS_QKV);
    const float* kmean = (const float*)(ws + WS_KMEAN);
    bf16_t* outA = (bf16_t*)(ws + WS_ATTA); bf16_t* outB = (bf16_t*)(ws + WS_ATTB); bf16_t* outC = (bf16_t*)(ws + WS_ATTC);
    if (wid >= 4) __builtin_amdgcn_s_setprio(1);
    const bool a_static = (gridDim.x == 256);
    if (a_static) {
        int t2 = tid; asm volatile("" : "+v"(t2));
        const int lane = t2 & 63;
        WaveCtx c; c.lane = lane; c.q = lane & 31; c.h = lane >> 5; c.vl = lds + wid * VTILE;
        { const int i = lane & 15, qq = i >> 2, pp = i & 3, blk = (lane >> 4) & 1; c.troff = (4 * c.h + qq) * VROW + (16 * blk + 4 * pp) * 2; }
        const int g8 = (int)blockIdx.x, jb = g8 >> 3;
        unit_A2(qkv, outA, g8 & 7, jb >> 3, jb & 7, wid, lds, c);
        __syncthreads();
    }
    for (int rb = 0; rb < REP_B; ++rb) {
        unsigned* ctrB = (unsigned*)(ws + WS_CTR) + 4096 + (layer * 2 + rb) * 64;
        LAS unsigned* qw = (LAS unsigned*)(lds + 131072 + 192);
        for (;;) {
            int t2 = tid; asm volatile("" : "+v"(t2));
            const int lane = t2 & 63;
            WaveCtx c; c.lane = lane; c.q = lane & 31; c.h = lane >> 5; c.vl = lds;
            { const int i = lane & 15, qq = i >> 2, pp = i & 3, blk = (lane >> 4) & 1; c.troff = (4 * c.h + qq) * VROW + (16 * blk + 4 * pp) * 2; }
            __syncthreads();
            if (t2 == 0) *qw = atomicAdd(ctrB, 1u);
            __syncthreads();
            const unsigned u = (unsigned)__builtin_amdgcn_readfirstlane((int)*qw);
            const unsigned ngu = (gridDim.x == 256) ? 128u : 0u;
            if (u >= 384u + ngu) break;
            if (u >= 192u && u < 192u + ngu) {
                pg8::StaticOrder so; so.init(M, NQKVG, 256, (int)(u - 192u));
                OneUnit S1; so.next(7, S1.u0);
                pg8::Gemm g{(const bf16_t*)(ws + WS_H), (const bf16_t*)(ws + WS_W + W_QKVG), M, NQKVG, DM};
                EpiQKVG E{(bf16_t*)(ws + WS_QKV), (bf16_t*)(ws + WS_GATES), p.b_gate + (size_t)layer * NG, (const float*)(ws + WS_COS), (const float*)(ws + WS_SIN), (float*)(ws + WS_KMEAN)};
                pg8::gemm_phase<EpiQKVG, OneUnit, false, GSP2>(lds, g, S1, E, t2);
                if (wid >= 4) __builtin_amdgcn_s_setprio(1);
                continue;
            }
            const unsigned ub = (u < 192u) ? u : u - ngu;
            const int qb = 7 - (int)(ub / 48u), r2 = (int)(ub % 48u);
            wg_unit_B(qkv, kmean, outB, r2 / 6, r2 % 6, qb, lds, wid, c, t2);
        }
        __syncthreads();
    }
    const int qid = blockIdx.x & 7;
    for (int rac = 0; rac < REP_AC; ++rac) {
    unsigned* ctr = (unsigned*)(ws + WS_CTR) + ((layer * 8 + qid) * 2 + rac) * 64;
    for (;;) {
        int t2 = tid; asm volatile("" : "+v"(t2));
        const int lane = t2 & 63;
        WaveCtx c; c.lane = lane; c.q = lane & 31; c.h = lane >> 5; c.vl = lds + wid * VTILE;
        { const int i = lane & 15, qq = i >> 2, pp = i & 3, blk = (lane >> 4) & 1; c.troff = (4 * c.h + qq) * VROW + (16 * blk + 4 * pp) * 2; }
        unsigned u = 0;
        if (lane == 0) u = atomicAdd(ctr, 1u);
        u = (unsigned)__builtin_amdgcn_readfirstlane((int)u);
        if (a_static) u += 256u;
        if (u >= 640u) break;
        const int wgu = (int)(u >> 3) * 8 + qid, sub = (int)(u & 7);
        if (wgu < 256) { unit_A(qkv, outA, wgu >> 5, (wgu & 31) >> 3, wgu & 7, sub, c); }
        else { const int v = (int)(u >> 3) - 32;
               unit_C(qkv, outC, qid, v % 6, (7 - v / 6) * 8 + sub, c); }
    }
    }
    __builtin_amdgcn_s_setprio(0);
}

__device__ __forceinline__ void phase0(const Params& p, LAS unsigned char* lds, const int tid) {
    const int lane = tid & 63, wid = tid >> 6;
    LAS float* cact = (LAS float*)lds;
    if (blockIdx.x == 0) { for (int i = tid; i < 4096 + DEPTH * 2 * 64; i += NTHR) ((unsigned*)(p.ws + WS_CTR))[i] = 0u; }
    {
        float* cosT = (float*)(p.ws + WS_COS); float* sinT = (float*)(p.ws + WS_SIN);
        for (int i = blockIdx.x * NTHR + tid; i < SEQ * 32; i += gridDim.x * NTHR) {
            const int pos = i >> 5, j = i & 31;
            const float inv = exp2f(-(float)j * 0.41524101186092029f);
            const float ang = (float)pos * inv;
            double a = (double)ang; const double twopi = 6.283185307179586476925;
            a -= twopi * rint(a / twopi);
            const double a2 = a * a;
            double cs = 1.0, term = 1.0, sn = a, ts = a;
#pragma unroll 1
            for (int k = 1; k <= 14; ++k) { term *= -a2 / (double)((2 * k - 1) * (2 * k)); cs += term; ts *= -a2 / (double)((2 * k) * (2 * k + 1)); sn += ts; }
            cosT[i] = (float)cs; sinT[i] = (float)sn;
        }
    }
    for (int i = blockIdx.x * NTHR + tid; i < 8 * 64 * 64; i += 256 * NTHR) { if (blockIdx.x < 256) ((unsigned*)(p.ws + WS_CNT))[i] = 0u; }
    for (int i = blockIdx.x * NTHR + tid; i < M * 16; i += 256 * NTHR) { if (blockIdx.x < 256) *(u32x4*)((bf16_t*)(p.ws + WS_ATTA) + (size_t)(i >> 4) * 384 + 256 + (i & 15) * 8) = (u32x4){0u, 0u, 0u, 0u}; }
    for (int i = tid; i < NB * DM; i += NTHR) { const float v = p.c[i]; cact[i] = v / (1.0f + __expf(-v)); }
    __syncthreads();
    float* mod = (float*)(p.ws + WS_MOD);
    LAS float* red2 = (LAS float*)(lds + 32768);
    const int hw = tid >> 5, cl = tid & 31;
    for (int unit = blockIdx.x; unit < DEPTH * 192; unit += gridDim.x) {
        const int l = unit / 192, n0 = (unit % 192) * 32;
        const float* W = p.w_ada + (size_t)l * DM * 6 * DM + (size_t)(hw * 64) * 6 * DM + n0 + cl;
        float a[8];
#pragma unroll
        for (int b = 0; b < 8; ++b) a[b] = 0.f;
#pragma unroll 1
        for (int kb = 0; kb < 64; kb += 16) {
            float w[16];
#pragma unroll
            for (int j = 0; j < 16; ++j) w[j] = W[(size_t)(kb + j) * 6 * DM];
#pragma unroll
            for (int j = 0; j < 16; ++j)
#pragma unroll
                for (int b = 0; b < 8; ++b) a[b] += cact[b * DM + hw * 64 + kb + j] * w[j];
        }
#pragma unroll
        for (int b = 0; b < 8; ++b) red2[(hw * 8 + b) * 32 + cl] = a[b];
        __syncthreads();
        if (tid < 256) {
            const int b = tid >> 5; float sum = 0.f;
#pragma unroll
            for (int h2 = 0; h2 < 16; ++h2) sum += red2[(h2 * 8 + b) * 32 + cl];
            mod[((size_t)l * NB + b) * 6 * DM + n0 + cl] = sum + p.b_ada[(size_t)l * 6 * DM + n0 + cl];
        }
        __syncthreads();
    }
}
__device__ __forceinline__ void norm_rows(const float* x, const float* g, const float* modl  , int sh_off, int sc_off, bf16_t* h, int gw, int ngw, int lane) {
    f32x4 gv[4];
#pragma unroll
    for (int j = 0; j < 4; ++j) gv[j] = *((const f32x4*)g + lane + 64 * j);
    for (int row = gw; row < M; row += ngw) {
        const f32x4* xr = (const f32x4*)(x + (size_t)row * DM) + lane;
        f32x4 v[4]; float ss = 0.f;
#pragma unroll
        for (int j = 0; j < 4; ++j) { v[j] = xr[64 * j]; ss += (v[j].x * v[j].x + v[j].y * v[j].y) + (v[j].z * v[j].z + v[j].w * v[j].w); }
        const float rstd = 1.0f / sqrtf(wave_sum(ss) * (1.0f / DM) + NORM_EPS);
        const float* mb = modl + (size_t)(row >> 11) * 6 * DM;
        unsigned long long* o8 = (unsigned long long*)(h + (size_t)row * DM) + lane;
#pragma unroll
        for (int j = 0; j < 4; ++j) {
            const f32x4 sc = *((const f32x4*)(mb + sc_off) + lane + 64 * j), sh = *((const f32x4*)(mb + sh_off) + lane + 64 * j);
            const f32x4 y = v[j] * rstd * gv[j] * (sc + 1.0f) + sh;
            o8[64 * j] = (unsigned long long)pk2(y.x, y.y) | ((unsigned long long)pk2(y.z, y.w) << 32);
        }
    }
}
__device__ __forceinline__ void final_norm(float* x, const float* g, int gw, int ngw, int lane) {
    f32x4 gv[4];
#pragma unroll
    for (int j = 0; j < 4; ++j) gv[j] = *((const f32x4*)g + lane + 64 * j);
    for (int row = gw; row < M; row += ngw) {
        f32x4* xr = (f32x4*)(x + (size_t)row * DM) + lane;
        f32x4 v[4]; float ss = 0.f;
#pragma unroll
        for (int j = 0; j < 4; ++j) { v[j] = xr[64 * j]; ss += (v[j].x * v[j].x + v[j].y * v[j].y) + (v[j].z * v[j].z + v[j].w * v[j].w); }
        const float rstd = 1.0f / sqrtf(wave_sum(ss) * (1.0f / DM) + NORM_EPS);
#pragma unroll
        for (int j = 0; j < 4; ++j) xr[64 * j] = v[j] * rstd * gv[j];
    }
}
__device__ __forceinline__ void convert_weights(const Params& p, unsigned char* ws, int l, LAS unsigned char* lds, int gw, int ngw, int wid, int lane) {
    LAS float* scr = (LAS float*)(lds + wid * 16384);
    unsigned char* wb = ws + WS_W;
    constexpr int I_IN = 16 * 144, I_G = 16 * 96, I_A = 4 * 32, I_B = 6 * 32, I_O = 16 * 32, I_GU = 16 * 176, I_D = 44 * 32;
    constexpr int NIT = I_IN + I_G + I_A + 2 * I_B + I_O + I_GU + I_D;
    for (int it = gw; it < NIT; it += ngw) {
        int r = it;
        if (r < I_IN) { transpose_item(p.w_in + (size_t)l * DM * LDQ, DM, LDQ, (bf16_t*)(wb + W_QKVG), DM, 0, 1, scr, r, lane); continue; } r -= I_IN;
        if (r < I_G) { transpose_item(p.w_gate + (size_t)l * DM * NG, DM, NG, (bf16_t*)(wb + W_QKVG), DM, LDQ, 0, scr, r, lane); continue; } r -= I_G;
        if (r < I_A) { transpose_item(p.w_br_a + (size_t)l * 256 * DM, 256, DM, (bf16_t*)(wb + W_A), 384, 0, 0, scr, r, lane); continue; } r -= I_A;
        if (r < I_B) { transpose_item(p.w_br_b + (size_t)l * 384 * DM, 384, DM, (bf16_t*)(wb + W_B), 384, 0, 0, scr, r, lane); continue; } r -= I_B;
        if (r < I_B) { transpose_item(p.w_br_c + (size_t)l * 384 * DM, 384, DM, (bf16_t*)(wb + W_C), 384, 0, 0, scr, r, lane); continue; } r -= I_B;
        if (r < I_O) { transpose_item(p.w_out + (size_t)l * DM * DM, DM, DM, (bf16_t*)(wb + W_O), DM, 0, 0, scr, r, lane); continue; } r -= I_O;
        if (r < I_GU) { transpose_item(p.w_gu + (size_t)l * DM * NGU, DM, NGU, (bf16_t*)(wb + W_GU), DM, 0, 2, scr, r, lane); continue; } r -= I_GU;
        transpose_item(p.w_down + (size_t)l * DFF * DM, DFF, DM, (bf16_t*)(wb + W_D), DFF, 0, 0, scr, r, lane);
    }
    { unsigned z = 0u; asm volatile("" : "+v"(z));
      for (int r = gw; r < DM; r += ngw) { if (lane < 16) *(u32x4*)((bf16_t*)(wb + W_A) + (size_t)r * 384 + 256 + lane * 8) = (u32x4){z, z, z, z}; } }
}

constexpr int PPL = 7;
constexpr int N_PHASES = 1 + PPL * DEPTH;
__global__ void __launch_bounds__(NTHR, 2) fwd_kernel(Params p) {
    extern __shared__ __attribute__((aligned(16))) unsigned char lds_raw[];
    LAS unsigned char* lds = (LAS unsigned char*)lds_raw;
    const int G = gridDim.x, ngw = G * NWAVES;
    volatile LAS unsigned* bst = (volatile LAS unsigned*)(lds + 131072 + 64);
    if (threadIdx.x < 2) bst[threadIdx.x] = 0u;
    __syncthreads();
    (void)xcd_barrier_post((unsigned*)(p.ws + WS_BAR), bst);
    if (p.ph_lo == 0) {
        int tid = threadIdx.x; asm volatile("" : "+v"(tid));
        for (int rep = 0; rep < REP_P0; ++rep) { phase0(p, lds, tid); __syncthreads(); }
        if (p.ph_hi > 1) xcd_barrier((unsigned*)(p.ws + WS_BAR), (volatile LAS unsigned*)(lds + 131072 + 64), tid);
        if (p.ph_hi < 0) cg::this_grid().sync();
    }
    const int ph_a = p.ph_lo < 1 ? 1 : p.ph_lo, ph_b = p.ph_hi;
    const int wid_s = __builtin_amdgcn_readfirstlane((int)(threadIdx.x >> 6));
    for (int ph = ph_a; ph < ph_b; ++ph) {
        unsigned ones = ~0u; asm volatile("" : "+s"(ones));
        int tid = wid_s * 64 + (int)__builtin_amdgcn_mbcnt_hi(ones, __builtin_amdgcn_mbcnt_lo(ones, 0u)); asm volatile("" : "+v"(tid));
        unsigned char* ws = p.ws; asm volatile("" : "+s"(ws));
        float* mod = (float*)(ws + WS_MOD);
        bf16_t* H = (bf16_t*)(ws + WS_H); bf16_t* QKV = (bf16_t*)(ws + WS_QKV); bf16_t* GATES = (bf16_t*)(ws + WS_GATES);
        bf16_t* MERGED = (bf16_t*)(ws + WS_MERGED); bf16_t* ACT = (bf16_t*)(ws + WS_QKV);
        unsigned char* wb = ws + WS_W;
        {
            const int l = (ph - 1) / PPL, k = (ph - 1) % PPL;
            const float* modl = mod + (size_t)l * NB * 6 * DM;
            const float* xin = (l == 0) ? p.x : p.out;
            switch (k) {
#if PHEN(0)
            case 0: {
                float* km = (float*)(ws + WS_KMEAN);
                if (blockIdx.x == 0) { for (int i = tid; i < NB * 6 * 8 * 64; i += NTHR) km[i] = 0.f; }
                const int lane = tid & 63, wid = __builtin_amdgcn_readfirstlane(tid >> 6), gw = blockIdx.x * NWAVES + wid;
                convert_weights(p, ws, l, lds, gw, ngw, wid, lane);
                if (l == 0) norm_rows(p.x, p.norm1_g, modl, 0, DM, H, gw, ngw, lane);
            } break;
#endif
#if PHEN(1)
            case 1: {
                pg8::Gemm g{H, (const bf16_t*)(wb + W_QKVG), M, NQKVG, DM}; LimitOrder S; S.base.init(M, NQKVG, G, (int)blockIdx.x); S.lim = (G == 256) ? 7 : 1000;
                EpiQKVG E{QKV, GATES, p.b_gate + (size_t)l * NG, (const float*)(ws + WS_COS), (const float*)(ws + WS_SIN), (float*)(ws + WS_KMEAN)};
                pg8::gemm_phase<EpiQKVG, LimitOrder, GALIGN, GSP2>(lds, g, S, E, tid);
            } break;
#endif
#if PHEN(2)
            case 2: for (int rep = 0; rep < REP_ATT; ++rep) { attn_phase(p, ws, l, lds, tid, rep); __syncthreads(); } break;
#endif
#if PHEN(3)
            case 3: {
                pg8::Gemm g{(const bf16_t*)(ws + WS_ATTA), (const bf16_t*)(wb + W_A), 3 * M, 3 * DM, 384};
                BranchOrder S; S.base.init(M, DM, G, (int)blockIdx.x);
                EpiBranch E{GATES, MERGED};
                pg8::gemm_phase<EpiBranch, BranchOrder, GALIGN, GSP2>(lds, g, S, E, tid);
            } break;
#endif
#if PHEN(4)
            case 4: {
                pg8::Gemm g{MERGED, (const bf16_t*)(wb + W_O), M, DM, DM}; pg8::StaticOrder S; S.init(M, DM, G, (int)blockIdx.x);
                RowStats rs{(unsigned*)(ws + WS_XBUF), (unsigned*)(ws + WS_CNT) + (size_t)(2 * l) * 64 * 64};
                EpiResidNorm E{l == 0 ? p.x : nullptr, (const bf16_t*)(ws + WS_X16), (bf16_t*)(ws + WS_GATES), nullptr, modl + 2 * DM, H, p.norm2_g + (size_t)l * DM, modl + 4 * DM, modl + 3 * DM, rs, 0};
                pg8::gemm_phase<EpiResidNorm, pg8::StaticOrder, false, GSP2>(lds, g, S, E, tid);
            } break;
#endif
#if PHEN(6)
            case 5: {
                pg8::Gemm g{H, (const bf16_t*)(wb + W_GU), M, NGU, DM}; pg8::StaticOrder S; S.init(M, NGU, G, (int)blockIdx.x);
                EpiSwiGLU E{ACT};
                pg8::gemm_phase<EpiSwiGLU, pg8::StaticOrder, GALIGN, GSP2>(lds, g, S, E, tid);
            } break;
#endif
#if PHEN(7)
            case 6: {
                pg8::Gemm g{ACT, (const bf16_t*)(wb + W_D), M, DM, DFF}; pg8::StaticOrder S; S.init(M, DM, G, (int)blockIdx.x);
                RowStats rs{(unsigned*)(ws + WS_XBUF), (unsigned*)(ws + WS_CNT) + (size_t)(2 * l + 1) * 64 * 64};
                const bool fin = (l == DEPTH - 1);
                const float* modn = mod + (size_t)(fin ? l : l + 1) * NB * 6 * DM;
                EpiResidNorm E{nullptr, (const bf16_t*)(ws + WS_GATES), (bf16_t*)(ws + WS_X16), p.out, modl + 5 * DM, H, fin ? p.final_g : p.norm1_g + (size_t)(l + 1) * DM, modn + DM, modn, rs, fin ? 1 : 0};
                pg8::gemm_phase<EpiResidNorm, pg8::StaticOrder, false, GSP2>(lds, g, S, E, tid);
            } break;
#endif
            default: break;
            }
        }
        if (ph + 1 < p.ph_hi) { for (int rep = 0; rep < REP_SYNC; ++rep) xcd_barrier((unsigned*)(ws + WS_BAR), (volatile LAS unsigned*)(lds + 131072 + 64), tid); }
    }
}

extern "C" void kernel_launch(void* const* d_in, const int* in_sizes, int n_in, void* d_out, int out_size, void* d_ws, size_t ws_size, hipStream_t stream) {
    static int grid = 0;
    if (grid == 0) {
        if (n_in != 16 || out_size != M * DM || ws_size < WS_END) { fprintf(stderr, "kernel_launch: unexpected sizes n_in %d out %d ws %zu\n", n_in, out_size, ws_size); grid = -1; return; }
        int dev = 0, cus = 0, per_cu = 0;
        if (hipGetDevice(&dev) != hipSuccess || hipDeviceGetAttribute(&cus, hipDeviceAttributeMultiprocessorCount, dev) != hipSuccess) { grid = -1; return; }
        if (hipFuncSetAttribute((const void*)fwd_kernel, hipFuncAttributeMaxDynamicSharedMemorySize, LDS_BYTES) != hipSuccess) { fprintf(stderr, "kernel_launch: hipFuncSetAttribute failed\n"); grid = -1; return; }
        if (hipOccupancyMaxActiveBlocksPerMultiprocessor(&per_cu, (const void*)fwd_kernel, NTHR, LDS_BYTES) != hipSuccess || per_cu < 1) { fprintf(stderr, "kernel_launch: occupancy query says %d\n", per_cu); per_cu = 1; }
        (void)hipGetLastError();
        grid = cus * 1;
    }
    if (grid < 0) return;
    if (hipMemsetAsync((char*)d_ws + WS_BAR, 0, XCD_BAR_WORDS * 4, stream) != hipSuccess) { fprintf(stderr, "kernel_launch: memset failed\n"); return; }
    Params p{};
    p.x = (const float*)d_in[0]; p.c = (const float*)d_in[1]; p.w_ada = (const float*)d_in[2]; p.b_ada = (const float*)d_in[3]; p.norm1_g = (const float*)d_in[4];
    p.w_in = (const float*)d_in[5]; p.w_br_a = (const float*)d_in[6]; p.w_br_b = (const float*)d_in[7]; p.w_br_c = (const float*)d_in[8]; p.w_gate = (const float*)d_in[9];
    p.b_gate = (const float*)d_in[10]; p.w_out = (const float*)d_in[11]; p.norm2_g = (const float*)d_in[12]; p.w_gu = (const float*)d_in[13]; p.w_down = (const float*)d_in[14];
    p.final_g = (const float*)d_in[15];
    p.out = (float*)d_out; p.ws = (unsigned char*)d_ws;
#if MK_MULTI_LAUNCH
    for (int ph = 0; ph < N_PHASES; ++ph) {
        p.ph_lo = ph; p.ph_hi = ph + 1;
        hipLaunchKernelGGL(fwd_kernel, dim3(grid), dim3(NTHR), LDS_BYTES, stream, p);
    }
#else
    p.ph_lo = 0; p.ph_hi = N_PHASES;
    void* args[] = {&p};
    hipError_t e = hipLaunchCooperativeKernel((const void*)fwd_kernel, dim3(grid), dim3(NTHR), args, LDS_BYTES, stream);
    if (e != hipSuccess) fprintf(stderr, "cooperative launch failed: %s (grid %d)\n", hipGetErrorString(e), grid);
#endif
}
```
